# Optimizing an MI355X kernel written in HIP

```python
import jax, jax.numpy as jnp
from jax import lax
import numpy as np

D_MODEL = 1024
BATCH = 32
SEQ = 2048
DEPTH = 1

CHUNK = 64
Q_BLOCK = 128
N_MEM = 256
EPS = 1e-6

HG_HEADS = 4
HG_DK = 128
HG_DV = 128
HG_WIDTH = HG_HEADS * HG_DK
FOX_HEADS = 8
FOX_DH = 64
FOX_WIDTH = FOX_HEADS * FOX_DH
MEM_HEADS = 4
MEM_DH = 128
MEM_WIDTH = MEM_HEADS * MEM_DH
N_BRANCH = 3
D_FF = 2816
CONV_W = 3

IN_SPLITS = (HG_WIDTH, HG_WIDTH, HG_WIDTH, HG_WIDTH,
             FOX_WIDTH, FOX_WIDTH, FOX_WIDTH, FOX_HEADS,
             MEM_WIDTH, N_BRANCH * D_MODEL)
IN_COLS = 4 * HG_WIDTH + 3 * FOX_WIDTH + FOX_HEADS + MEM_WIDTH + N_BRANCH * D_MODEL

kernel_name = "hybrid_hgrn2_fox_memory_convglu"


def _split_points():
    pts, acc = [], 0
    for s in IN_SPLITS[:-1]:
        acc += s
        pts.append(acc)
    return pts


def _rmsnorm(x, g):
    xf = x.astype(jnp.float32)
    return xf * lax.rsqrt(jnp.mean(xf * xf, axis=-1, keepdims=True) + EPS) * g.astype(jnp.float32)


def _hgrn2_mixer(q, f_logit, i, g_out, lb, norm_g):
    B, T, _ = q.shape
    n = T // CHUNK

    def heads(z):
        return z.reshape(B, n, CHUNK, HG_HEADS, -1).transpose(1, 0, 3, 2, 4)

    f = lb + (1.0 - lb) * jax.nn.sigmoid(f_logit.astype(jnp.float32))
    qh = heads(jax.nn.silu(q.astype(jnp.float32)))
    kh = heads(1.0 - f)
    ih = heads(i.astype(jnp.float32))
    G = jnp.cumsum(heads(jnp.log(f)), axis=3)
    causal = jnp.tril(jnp.ones((CHUNK, CHUNK), dtype=bool))[:, :, None]

    def step(S, inp):
        qc, kc, ic, Gc = inp
        diff = Gc[:, :, :, None, :] - Gc[:, :, None, :, :]
        decay = jnp.exp(jnp.where(causal, diff, -jnp.inf))
        A = jnp.einsum('bhtc,bhsc,bhtsc->bhts', qc, kc, decay)
        o = (jnp.einsum('bhts,bhsv->bhtv', A, ic)
             + jnp.einsum('bhtc,bhcv->bhtv', qc * jnp.exp(Gc), S))
        G_last = Gc[:, :, -1, :]
        S_new = (S * jnp.exp(G_last)[..., None]
                 + jnp.einsum('bhsc,bhsv->bhcv', kc * jnp.exp(G_last[:, :, None, :] - Gc), ic))
        return S_new, o

    S0 = jnp.zeros((B, HG_HEADS, HG_DK, HG_DV), jnp.float32)
    _, o = lax.scan(step, S0, (qh, kh, ih, G))
    o = o.transpose(1, 0, 3, 2, 4).reshape(B, T, HG_HEADS, HG_DV)
    o = _rmsnorm(o, norm_g).reshape(B, T, HG_WIDTH)
    return o * jax.nn.silu(g_out.astype(jnp.float32))


def _fox_mixer(q, k, v, f_logit, f_bias, q_g, k_g):
    B, T, _ = q.shape
    qh = _rmsnorm(q.reshape(B, T, FOX_HEADS, FOX_DH), q_g).transpose(0, 2, 1, 3)
    kh = _rmsnorm(k.reshape(B, T, FOX_HEADS, FOX_DH), k_g).transpose(0, 2, 1, 3)
    vh = v.astype(jnp.float32).reshape(B, T, FOX_HEADS, FOX_DH).transpose(0, 2, 1, 3)
    log_f = jax.nn.log_sigmoid(f_logit.astype(jnp.float32) + f_bias.astype(jnp.float32))
    Fc = jnp.cumsum(log_f, axis=1).transpose(0, 2, 1)
    scale = FOX_DH ** -0.5
    outs = []
    for blk in range(T // Q_BLOCK):
        lo, hi = blk * Q_BLOCK, (blk + 1) * Q_BLOCK
        s = (jnp.einsum('bhqd,bhkd->bhqk', qh[:, :, lo:hi], kh[:, :, :hi]) * scale
             + Fc[:, :, lo:hi, None] - Fc[:, :, None, :hi])
        mask = (lo + jnp.arange(Q_BLOCK))[:, None] >= jnp.arange(hi)[None, :]
        p = jax.nn.softmax(jnp.where(mask, s, -jnp.inf), axis=-1)
        outs.append(jnp.einsum('bhqk,bhkd->bhqd', p, vh[:, :, :hi]))
    o = jnp.concatenate(outs, axis=2)
    return o.transpose(0, 2, 1, 3).reshape(B, T, FOX_WIDTH)


def _memory_mixer(q, mem_kv, q_g, k_g):
    B, T, _ = q.shape
    M = mem_kv.shape[1]
    qh = _rmsnorm(q.reshape(B, T, MEM_HEADS, MEM_DH), q_g)
    mk, mv = jnp.split(mem_kv, 2, axis=-1)
    kh = _rmsnorm(mk.reshape(B, M, MEM_HEADS, MEM_DH), k_g)
    vh = mv.astype(jnp.float32).reshape(B, M, MEM_HEADS, MEM_DH)
    s = jnp.einsum('bthd,bmhd->bhtm', qh, kh) * (MEM_DH ** -0.5)
    p = jax.nn.softmax(s, axis=-1)
    return jnp.einsum('bhtm,bmhd->bthd', p, vh).reshape(B, T, MEM_WIDTH)


def _conv_glu_ffn(h, w_up, conv_w, conv_b, w_down):
    T = h.shape[1]
    a, v = jnp.split(h @ w_up.astype(jnp.float32), 2, axis=-1)
    ap = jnp.pad(a, ((0, 0), (CONV_W - 1, 0), (0, 0)))
    a = sum(ap[:, j:j + T] * conv_w[j].astype(jnp.float32) for j in range(CONV_W)) + conv_b.astype(jnp.float32)
    return (jax.nn.gelu(a, approximate=False) * v) @ w_down.astype(jnp.float32)


def setup_inputs(seed: int = 0) -> dict:
    key = jax.random.key(seed)
    ks = jax.random.split(key, 24)
    f32 = jnp.float32
    L = DEPTH

    def nrm(k, shape, fan_in):
        return jax.random.normal(k, shape, f32) * (fan_in ** -0.5)

    def gain(k, shape):
        return 1.0 + 0.02 * jax.random.normal(k, shape, f32)

    return {
        "x": jax.random.normal(ks[0], (BATCH, SEQ, D_MODEL), f32),
        "mem": jax.random.normal(ks[1], (BATCH, N_MEM, D_MODEL), f32),
        "norm_mix_g": gain(ks[2], (L, D_MODEL)),
        "norm_mem_g": gain(ks[3], (L, D_MODEL)),
        "w_in": nrm(ks[4], (L, D_MODEL, IN_COLS), D_MODEL),
        "hgrn_lb_logits": 0.1 * jax.random.normal(ks[5], (L + 1, HG_WIDTH), f32),
        "hgrn_norm_g": gain(ks[6], (L, HG_DV)),
        "fox_f_bias": 1.0 + 0.1 * jax.random.normal(ks[7], (L, FOX_HEADS), f32),
        "fox_q_norm_g": gain(ks[8], (L, FOX_DH)),
        "fox_k_norm_g": gain(ks[9], (L, FOX_DH)),
        "mem_kv_w": nrm(ks[10], (L, D_MODEL, 2 * MEM_WIDTH), D_MODEL),
        "mem_q_norm_g": gain(ks[11], (L, MEM_DH)),
        "mem_k_norm_g": gain(ks[12], (L, MEM_DH)),
        "w_br_hgrn": nrm(ks[13], (L, HG_WIDTH, D_MODEL), HG_WIDTH),
        "w_br_fox": nrm(ks[14], (L, FOX_WIDTH, D_MODEL), FOX_WIDTH),
        "w_br_mem": nrm(ks[15], (L, MEM_WIDTH, D_MODEL), MEM_WIDTH),
        "w_out": nrm(ks[16], (L, D_MODEL, D_MODEL), D_MODEL),
        "norm_ffn_g": gain(ks[17], (L, D_MODEL)),
        "ffn_w_up": nrm(ks[18], (L, D_MODEL, 2 * D_FF), D_MODEL),
        "ffn_conv_w": nrm(ks[19], (L, CONV_W, D_FF), CONV_W),
        "ffn_conv_b": 0.02 * jax.random.normal(ks[20], (L, D_FF), f32),
        "ffn_w_down": nrm(ks[21], (L, D_FF, D_MODEL), D_FF),
    }


def reference(x, mem, norm_mix_g, norm_mem_g, w_in, hgrn_lb_logits, hgrn_norm_g, fox_f_bias,
              fox_q_norm_g, fox_k_norm_g, mem_kv_w, mem_q_norm_g, mem_k_norm_g,
              w_br_hgrn, w_br_fox, w_br_mem, w_out, norm_ffn_g, ffn_w_up, ffn_conv_w,
              ffn_conv_b, ffn_w_down):
    B, T, _ = x.shape
    lower_bounds = jnp.cumsum(jax.nn.softmax(hgrn_lb_logits.astype(jnp.float32), axis=0), axis=0)
    pts = _split_points()
    for l in range(DEPTH):
        h = _rmsnorm(x, norm_mix_g[l])
        z = h @ w_in[l].astype(jnp.float32)
        (hq, hf, hi, hg, fq, fk, fv, ff, mq, gate_logits) = jnp.split(z, pts, axis=-1)
        y_a = _hgrn2_mixer(hq, hf, hi, hg, lower_bounds[l], hgrn_norm_g[l])
        y_b = _fox_mixer(fq, fk, fv, ff, fox_f_bias[l], fox_q_norm_g[l], fox_k_norm_g[l])
        mem_kv = _rmsnorm(mem, norm_mem_g[l]) @ mem_kv_w[l].astype(jnp.float32)
        y_c = _memory_mixer(mq, mem_kv, mem_q_norm_g[l], mem_k_norm_g[l])
        gates = jax.nn.sigmoid(gate_logits).reshape(B, T, N_BRANCH, D_MODEL)
        merged = (gates[:, :, 0] * (y_a @ w_br_hgrn[l].astype(jnp.float32))
                  + gates[:, :, 1] * (y_b @ w_br_fox[l].astype(jnp.float32))
                  + gates[:, :, 2] * (y_c @ w_br_mem[l].astype(jnp.float32)))
        x = x + (merged @ w_out[l].astype(jnp.float32)).astype(x.dtype)
        h2 = _rmsnorm(x, norm_ffn_g[l])
        x = x + _conv_glu_ffn(h2, ffn_w_up[l], ffn_conv_w[l], ffn_conv_b[l], ffn_w_down[l]).astype(x.dtype)
    return x
```

```cpp
#include <hip/hip_runtime.h>
#include <hip/hip_cooperative_groups.h>
#include <cstdio>
#include <cstdint>
namespace cg = cooperative_groups;

#define LAS __attribute__((address_space(3)))
typedef unsigned short bf16_t;
typedef short bf16x8 __attribute__((ext_vector_type(8)));
typedef float f32x4 __attribute__((ext_vector_type(4)));
typedef float f32x2 __attribute__((ext_vector_type(2)));
typedef unsigned u32x4 __attribute__((ext_vector_type(4)));
typedef unsigned u32x2 __attribute__((ext_vector_type(2)));

constexpr int NB = 32, NT = 2048, DM = 1024, MTOK = NB * NT, NMEM = 256, MMEM = NB * NMEM;
constexpr int INC = 7176, FFD = 2816;
constexpr float EPS = 1e-6f;
constexpr size_t MiB = 1u << 20;
constexpr size_t WS_CTL = 0, WS_WCAT = 1, WS_WBR = 17, WS_WOUT = 20, WS_WUP = 22, WS_WDOWN = 33, WS_FLOG = 40, WS_FC = 42, WS_SS = 44,
                 WS_MEMK = 48, WS_MEMVT = 56, WS_Z = 64, WS_GATES = 576, WS_ACC32 = 64, WS_MERGED = 320, WS_X1B = 448, WS_Y = 600;
constexpr int LDS_BYTES = 147456;
constexpr int LDS_X = 131072;

__device__ __forceinline__ unsigned f2bf(float f) { unsigned u = __builtin_bit_cast(unsigned, f); return (u + 0x7fffu + ((u >> 16) & 1u)) >> 16; }
typedef __bf16 bf16x2_t __attribute__((ext_vector_type(2)));
__device__ __forceinline__ unsigned pk2(float lo, float hi) { const f32x2 v = {lo, hi}; const bf16x2_t b = __builtin_convertvector(v, bf16x2_t); return __builtin_bit_cast(unsigned, b); }
__device__ __forceinline__ unsigned f2bf_hw(float f) { return pk2(f, 0.f) & 0xffffu; }
__device__ __forceinline__ float bflo(unsigned u) { return __builtin_bit_cast(float, u << 16); }
__device__ __forceinline__ float bfhi(unsigned u) { return __builtin_bit_cast(float, u & 0xffff0000u); }
__device__ __forceinline__ float bf1(bf16_t u) { return __builtin_bit_cast(float, (unsigned)u << 16); }
__device__ __forceinline__ int lane_id() { int l = (int)__builtin_amdgcn_mbcnt_hi(~0u, __builtin_amdgcn_mbcnt_lo(~0u, 0u)); asm volatile("" : "+v"(l)); return l; }
__device__ __forceinline__ int tid_from(int wv) { return wv * 64 + lane_id(); }
template <int O> __device__ __forceinline__ float sxor(float v) {
    if constexpr (O == 32) { auto rr = __builtin_amdgcn_permlane32_swap(__float_as_uint(v), __float_as_uint(v), false, false); const unsigned a = rr[0], b = rr[1]; return (lane_id() & 32) ? __uint_as_float(a) : __uint_as_float(b); }
    else return __int_as_float(__builtin_amdgcn_ds_swizzle(__float_as_int(v), (O << 10) | 0x1f));
}
__device__ __forceinline__ float xsum64(float v) { v += sxor<1>(v); v += sxor<2>(v); v += sxor<4>(v); v += sxor<8>(v); v += sxor<16>(v); v += sxor<32>(v); return v; }
__device__ __forceinline__ float xmax64(float v) { v = fmaxf(v, sxor<1>(v)); v = fmaxf(v, sxor<2>(v)); v = fmaxf(v, sxor<4>(v)); v = fmaxf(v, sxor<8>(v)); v = fmaxf(v, sxor<16>(v)); v = fmaxf(v, sxor<32>(v)); return v; }
__device__ __forceinline__ float wave_sum(float v) { return xsum64(v); }
__device__ __forceinline__ float sigmoidf_(float x) { return __builtin_amdgcn_rcpf(1.f + __builtin_amdgcn_exp2f(x * -1.4426950408889634f)); }

namespace pg8 {
constexpr int BM = 256, BK = 64, HALF = 128, HTB = HALF * BK * 2, NXCD = 8, WGM = 8;
__host__ __device__ __forceinline__ int lds_byte(int r, int c) { const int st = (r >> 4) * 2 + (c >> 5), rr = r & 15, cc = c & 31, ob = rr * 64 + cc * 2; return st * 1024 + (ob ^ (((ob >> 9) & 1) << 5)); }
__host__ __device__ __forceinline__ void stage_rc(int b, int& R, int& C) { const int st = b / 1024, sb = b % 1024, swz = sb ^ (((sb >> 9) & 1) << 5); R = (st >> 1) * 16 + swz / 64; C = (st & 1) * 32 + (swz % 64) / 2; }
__host__ __device__ __forceinline__ int perm32(int rho) { const int n = rho >> 4, i = rho & 15; return 8 * (i >> 2) + 4 * n + (i & 3); }
struct Unit { int pm, pn; };
struct Gemm { const bf16_t* A; const bf16_t* Bt; int K; };
__device__ __forceinline__ void swz_unit(int L, int nM, int nN, Unit& u) {
    int wgid = L; const int nwg = nM * nN; { const int q = nwg / NXCD, r = nwg % NXCD, xcd = wgid % NXCD, off = wgid / NXCD; wgid = (xcd < r ? xcd * (q + 1) : r * (q + 1) + (xcd - r) * q) + off; }
    const int nig = WGM * nN, gid = wgid / nig, fm = gid * WGM, gsz = (nM - fm) < WGM ? (nM - fm) : WGM;
    u.pm = fm + ((wgid % nig) % gsz); u.pn = (wgid % nig) / gsz;
}
__device__ __forceinline__ unsigned cvt_pk_bf16(float lo, float hi) { unsigned r; asm volatile("v_cvt_pk_bf16_f32 %0, %1, %2" : "=v"(r) : "v"(lo), "v"(hi)); return r; }
__device__ __forceinline__ f32x2 gelu_pk(f32x2 x) {
    const f32x2 u0 = x * 0.70710678f; f32x2 u; u.x = __builtin_amdgcn_fmed3f(u0.x, -3.2f, 3.2f); u.y = __builtin_amdgcn_fmed3f(u0.y, -3.2f, 3.2f);
    const f32x2 t = (u * u) * 0.1953125f - 1.0f;
    f32x2 p = t * 2.982273671e-03f + (-7.046153472e-03f);
    p = p * t + 7.957076705e-03f; p = p * t + (-1.521942819e-02f); p = p * t + 3.318292224e-02f; p = p * t + (-5.471928813e-02f); p = p * t + 8.062700147e-02f;
    p = p * t + (-1.136467381e-01f); p = p * t + 1.543549678e-01f; p = p * t + (-2.173077339e-01f); p = p * t + 4.413341836e-01f;
    const f32x2 e = u * p, hx = x * 0.5f;
    return hx + hx * e;
}

template <class Epi, class Sched>
__device__ __forceinline__ void gemm_phase(LAS unsigned char* lds, const int K, const Sched& S, const Epi& E, const int wv) {
    const int tid = tid_from(wv);
    const int wid = wv, lane = tid & 63, wr = wid >> 2, wc = wid & 3, fr = lane & 15, fq = lane >> 4;
    const int nt = K / BK;
    unsigned voffA[2], voffB[2];
#pragma unroll
    for (int i = 0; i < 2; ++i) { int R, C; stage_rc(tid * 16 + i * 8192, R, C); const int Rb = (R & ~31) + perm32(R & 31);
        voffA[i] = (unsigned)(R * K + C) * 2u; voffB[i] = (unsigned)(Rb * K + C) * 2u; }
    const size_t kstep = (size_t)(BK * 2);
    const size_t hstep = (size_t)HALF * K * 2;
    const unsigned ldsw = (unsigned)wid * 1024u;
    const int aoff = lds_byte(wr * 64 + fr, fq * 8), boff = lds_byte(wc * 32 + fr, fq * 8);
#define PG8_SA(b, h) (((b) * 2 + (h)) * HTB)
#define PG8_SB(b, h) ((4 + (b) * 2 + (h)) * HTB)
#define PG8_STAGE(bufoff, gbase, voff) do { _Pragma("unroll") for (int _i = 0; _i < 2; ++_i) \
        __builtin_amdgcn_global_load_lds((const unsigned*)((const char*)(gbase) + (voff)[_i]), (LAS unsigned*)(lds + (bufoff) + ldsw + _i * 8192), 16, 0, 0); } while (0)
#define PG8_LDA(dst, b, h) do { _Pragma("unroll") for (int m = 0; m < 4; ++m) _Pragma("unroll") for (int k = 0; k < 2; ++k) dst[m][k] = *(const LAS bf16x8*)(lds + PG8_SA(b, h) + aoff + m * 2048 + k * 1024); } while (0)
#define PG8_LDB(dst, b, h) do { _Pragma("unroll") for (int n = 0; n < 2; ++n) _Pragma("unroll") for (int k = 0; k < 2; ++k) dst[n][k] = *(const LAS bf16x8*)(lds + PG8_SB(b, h) + boff + n * 2048 + k * 1024); } while (0)
#define PG8_MMA(ai, bj, At, Bt) do { __builtin_amdgcn_s_setprio(1); _Pragma("unroll") for (int m = 0; m < 4; ++m) _Pragma("unroll") for (int n = 0; n < 2; ++n) _Pragma("unroll") for (int k = 0; k < 2; ++k) \
        acc[ai][bj][m][n] = __builtin_amdgcn_mfma_f32_16x16x32_bf16(Bt[n][k], At[m][k], acc[ai][bj][m][n], 0, 0, 0); __builtin_amdgcn_s_setprio(0); } while (0)
#define PG8_WAIT_V(n) asm volatile("s_waitcnt vmcnt(" #n ")" ::: "memory")
#define PG8_WAIT_L(n) asm volatile("s_waitcnt lgkmcnt(" #n ")" ::: "memory")
#define PG8_BAR __builtin_amdgcn_s_barrier()
#define PG8_SCHED __builtin_amdgcn_sched_barrier(0)
    Unit cur, nxt; int ui = 0;
    if (!S.next(0, cur)) return;
    cur.pm = __builtin_amdgcn_readfirstlane(cur.pm); cur.pn = __builtin_amdgcn_readfirstlane(cur.pn);
    f32x4 acc[2][2][4][2];
#pragma unroll
    for (int a = 0; a < 2; ++a)
#pragma unroll
        for (int b = 0; b < 2; ++b)
#pragma unroll
            for (int m = 0; m < 4; ++m)
#pragma unroll
                for (int n = 0; n < 2; ++n) acc[a][b][m][n] = (f32x4){0.f, 0.f, 0.f, 0.f};
    bf16x8 At[4][2], B0[2][2], B1[2][2];
    const char* cA = S.aptr(cur); const char* cB = S.bptr(cur);
    PG8_STAGE(PG8_SB(0, 0), cB, voffB); PG8_STAGE(PG8_SB(0, 1), cB + hstep, voffB); PG8_STAGE(PG8_SA(0, 0), cA, voffA); PG8_STAGE(PG8_SA(0, 1), cA + hstep, voffA);
    if (wr == 1) PG8_BAR;
    PG8_WAIT_V(2); PG8_BAR;
    PG8_STAGE(PG8_SB(1, 0), cB + kstep, voffB); PG8_STAGE(PG8_SA(1, 0), cA + kstep, voffA); PG8_STAGE(PG8_SB(1, 1), cB + hstep + kstep, voffB);
    PG8_WAIT_V(6); PG8_BAR;
    for (;;) {
        const bool has_next = S.next(ui + 1, nxt);
        nxt.pm = __builtin_amdgcn_readfirstlane(nxt.pm); nxt.pn = __builtin_amdgcn_readfirstlane(nxt.pn);
        const char* nA = has_next ? S.aptr(nxt) : cA; const char* nB = has_next ? S.bptr(nxt) : cB;
        for (int t = 0; t < nt; t += 2) {
            const bool last = (t == nt - 2);
            const char* a1 = cA + (size_t)(t + 1) * kstep;
            const char* a2 = last ? nA : cA + (size_t)(t + 2) * kstep; const char* b2 = last ? nB : cB + (size_t)(t + 2) * kstep;
            const char* a3 = a2 + kstep; const char* b3 = b2 + kstep;
            PG8_LDB(B0, 0, 0); PG8_LDB(B1, 0, 1); PG8_SCHED; PG8_LDA(At, 0, 0); PG8_STAGE(PG8_SA(1, 1), a1 + hstep, voffA);
            PG8_WAIT_V(8); PG8_WAIT_L(0); PG8_BAR; PG8_MMA(0, 0, At, B0); PG8_MMA(0, 1, At, B1); PG8_BAR; PG8_SCHED;
            PG8_LDA(At, 0, 1); PG8_STAGE(PG8_SB(0, 0), b2, voffB); PG8_STAGE(PG8_SB(0, 1), b2 + hstep, voffB); PG8_STAGE(PG8_SA(0, 0), a2, voffA);
            PG8_WAIT_V(8); PG8_WAIT_L(0); PG8_BAR; PG8_MMA(1, 0, At, B0); PG8_MMA(1, 1, At, B1); PG8_BAR; PG8_SCHED;
            PG8_LDB(B0, 1, 0); PG8_LDB(B1, 1, 1); PG8_SCHED; PG8_LDA(At, 1, 0); PG8_STAGE(PG8_SA(0, 1), a2 + hstep, voffA);
            PG8_WAIT_V(8); PG8_WAIT_L(0); PG8_BAR; PG8_MMA(0, 0, At, B0); PG8_MMA(0, 1, At, B1); PG8_BAR; PG8_SCHED;
            PG8_LDA(At, 1, 1); PG8_STAGE(PG8_SB(1, 0), b3, voffB); PG8_STAGE(PG8_SB(1, 1), b3 + hstep, voffB); PG8_STAGE(PG8_SA(1, 0), a3, voffA);
            PG8_WAIT_V(8); PG8_WAIT_L(0); PG8_BAR; PG8_MMA(1, 0, At, B0); PG8_MMA(1, 1, At, B1); PG8_BAR; PG8_SCHED;
        }
        if (wr == 0) PG8_BAR;
        E(acc, cur, wr, wc, fr, fq);
        if (!has_next) break;
#pragma unroll
        for (int a = 0; a < 2; ++a)
#pragma unroll
            for (int b = 0; b < 2; ++b)
#pragma unroll
                for (int m = 0; m < 4; ++m)
#pragma unroll
                    for (int n = 0; n < 2; ++n) acc[a][b][m][n] = (f32x4){0.f, 0.f, 0.f, 0.f};
        cur = nxt; cA = nA; cB = nB; ++ui;
        if (wr == 1) PG8_BAR;
    }
    PG8_WAIT_V(0);
    PG8_BAR;
#undef PG8_SA
#undef PG8_SB
#undef PG8_STAGE
#undef PG8_LDA
#undef PG8_LDB
#undef PG8_MMA
#undef PG8_WAIT_V
#undef PG8_WAIT_L
#undef PG8_BAR
#undef PG8_SCHED
}
}
using pg8::Unit;
typedef f32x4 (&AccRef)[2][2][4][2];

struct SchedIn {
    int G, c; const char* H; const char* W;
    __device__ __forceinline__ bool next(int i, Unit& u) const {
        int L = i * G + c;
        if (L < 6656) { pg8::swz_unit(L, 256, 26, u); u.pn = u.pn < 12 ? u.pn : u.pn + 2; return true; }
        L -= 6656;
        if (L < 512) { u.pm = 1024 + (L & 1); u.pn = L >> 1; return true; }
        L -= 512;
        if (L < 64) { u.pm = 2048 + (L >> 1); u.pn = 28 + (L & 1); return true; }
        L -= 64;
        if (L < 64) { u.pm = 3072 + (L & 1); u.pn = L >> 1; return true; }
        return false;
    }
    __device__ __forceinline__ const char* aptr(const Unit& u) const { const int ty = u.pm >> 10, idx = u.pm & 1023;
        const long row = ty == 0 ? (long)idx * 256 : (ty == 1 ? (long)(12 + idx) * 256 : (ty == 2 ? (long)MTOK + idx * 256 : (long)(30 + idx) * 256));
        return ((ty & 1) ? W : H) + row * 2048; }
    __device__ __forceinline__ const char* bptr(const Unit& u) const { const int ty = u.pm >> 10;
        const long row = ty == 3 ? (long)MTOK + u.pn * 256 : (long)u.pn * 256;
        return ((ty & 1) ? H : W) + row * 2048; }
};
struct SchedMerge {
    int p; const char* A; const char* B;
    __device__ __forceinline__ bool next(int i, Unit& u) const {
        if (i >= 12) return false; const int pn = i / 3, j = i - 3 * pn; u.pm = j * 256 + p; u.pn = j * 4 + pn; return true;
    }
    __device__ __forceinline__ const char* aptr(const Unit& u) const { return A + (long)u.pm * 256 * 1024; }
    __device__ __forceinline__ const char* bptr(const Unit& u) const { return B + (long)u.pn * 256 * 1024; }
};
struct SchedPanel {
    int p; const char* A; const char* B; long rowb;
    __device__ __forceinline__ bool next(int i, Unit& u) const { if (i >= 4) return false; u.pm = p; u.pn = i; return true; }
    __device__ __forceinline__ const char* aptr(const Unit& u) const { return A + (long)u.pm * 256 * rowb; }
    __device__ __forceinline__ const char* bptr(const Unit& u) const { return B + (long)u.pn * 256 * rowb; }
};
struct SchedPlain {
    int G, c, nM, nN, rstride, roff; const char* A; const char* B; long rowb;
    __device__ __forceinline__ bool next(int i, Unit& u) const {
        const int L = i * G + c; if (L >= nM * nN) return false;
        pg8::swz_unit(L, nM, nN, u); return true;
    }
    __device__ __forceinline__ const char* aptr(const Unit& u) const { return A + ((long)u.pm * rstride + roff) * rowb; }
    __device__ __forceinline__ const char* bptr(const Unit& u) const { return B + (long)u.pn * 256 * rowb; }
};

struct EpiIn {
    bf16_t* z; bf16_t* gates; bf16_t* memk; bf16_t* memvt; const float* lbl; const float* gtab; LAS float* hs;
    __device__ __forceinline__ void operator()(AccRef acc, const Unit& u, int wr, int wc, int fr, int fq) const {
        const int ty = u.pm >> 10, idx = u.pm & 1023, pn = u.pn;
        bf16_t* base; size_t ldc; int mode = 0; int c0; int rbase;
        if (ty == 1) {
            const int tk = pn * 256 + wc * 32 + 8 * fq; const int b = tk >> 11;
            base = z + 6 * ((size_t)MTOK * 512) + (size_t)b * 512 * 2048; ldc = 2048; c0 = tk & 2047; rbase = idx * 256 + wr * 64 + fr;
        } else if (ty == 3) {
            const int mi = pn * 256 + wc * 32 + 8 * fq; const int b = mi >> 8;
            base = memvt + (size_t)b * 512 * 256; ldc = 256; c0 = mi & 255; rbase = idx * 256 + wr * 64 + fr;
        } else if (ty == 2) {
            base = memk; ldc = 512; c0 = (pn - 28) * 256 + wc * 32 + 8 * fq; rbase = idx * 256 + wr * 64 + fr; mode = 5;
        } else if (pn >= 16) {
            base = gates; ldc = 3072; c0 = (pn - 16) * 256 + wc * 32 + 8 * fq; rbase = idx * 256 + wr * 64 + fr; mode = 3;
        } else { const int reg = pn >> 1;
            base = z + (size_t)reg * ((size_t)MTOK * 512); ldc = 512; c0 = (pn & 1) * 256 + wc * 32 + 8 * fq; rbase = idx * 256 + wr * 64 + fr;
            mode = (reg == 0 || reg == 3) ? 1 : (reg == 1 ? 2 : ((reg == 4 || reg == 5) ? 4 : (reg == 7 ? 5 : 0)));
        }
        if (mode >= 4) {
            const int rloc = wr * 64 + fr; const bool wide = (mode == 5); const bool isq = wide ? (ty == 0) : (pn < 10);
#pragma unroll
            for (int ai = 0; ai < 2; ++ai)
#pragma unroll
                for (int m = 0; m < 4; ++m)
#pragma unroll
                    for (int bj = 0; bj < 2; ++bj) { const f32x4 a0 = acc[ai][bj][m][0], a1 = acc[ai][bj][m][1];
                        float sq = (a0[0] * a0[0] + a0[1] * a0[1]) + (a0[2] * a0[2] + a0[3] * a0[3]) + (a1[0] * a1[0] + a1[1] * a1[1]) + (a1[2] * a1[2] + a1[3] * a1[3]);
                        sq += sxor<16>(sq); sq += sxor<32>(sq);
                        if (fq == 0) hs[((rloc + ai * 128 + m * 16) * 2 + bj) * 4 + wc] = sq; }
            asm volatile("s_waitcnt lgkmcnt(0)" ::: "memory");
            __builtin_amdgcn_s_barrier();
            const float* gp = gtab + (wide ? (isq ? 128 : 256) + wc * 32 : (isq ? 0 : 64) + (wc & 1) * 32) + 8 * fq;
            const float gsc = isq ? (wide ? 0.08838834764831845f : 0.125f) * 1.4426950408889634f : 1.f;
            float gg[8];
#pragma unroll
            for (int i = 0; i < 8; ++i) gg[i] = gp[i] * gsc;
#pragma unroll
            for (int ai = 0; ai < 2; ++ai)
#pragma unroll
                for (int m = 0; m < 4; ++m)
#pragma unroll
                    for (int bj = 0; bj < 2; ++bj) { const LAS float* hp = hs + ((rloc + ai * 128 + m * 16) * 2 + bj) * 4; const f32x4 h4 = *(const LAS f32x4*)hp;
                        const float rs = wide ? __builtin_amdgcn_rsqf(((h4[0] + h4[1]) + (h4[2] + h4[3])) * (1.f / 128.f) + EPS) : __builtin_amdgcn_rsqf(((wc & 2) ? (h4[2] + h4[3]) : (h4[0] + h4[1])) * (1.f / 64.f) + EPS);
                        const f32x4 a0 = acc[ai][bj][m][0], a1 = acc[ai][bj][m][1];
                        u32x4 w; w.x = pk2(a0[0] * rs * gg[0], a0[1] * rs * gg[1]); w.y = pk2(a0[2] * rs * gg[2], a0[3] * rs * gg[3]); w.z = pk2(a1[0] * rs * gg[4], a1[1] * rs * gg[5]); w.w = pk2(a1[2] * rs * gg[6], a1[3] * rs * gg[7]);
                        *(u32x4*)(base + (size_t)(rbase + ai * 128 + m * 16) * ldc + c0 + bj * 128) = w; }
            return;
        }
#pragma unroll
        for (int bj = 0; bj < 2; ++bj) {
            float lb[8];
            if (mode == 2) {
#pragma unroll
                for (int i = 0; i < 8; ++i) { const float l0 = lbl[c0 + bj * 128 + i], l1 = lbl[512 + c0 + bj * 128 + i]; lb[i] = __builtin_amdgcn_rcpf(1.f + __expf(l1 - l0)); }
            }
#pragma unroll
            for (int ai = 0; ai < 2; ++ai)
#pragma unroll
                for (int m = 0; m < 4; ++m) { float v[8];
#pragma unroll
                    for (int i = 0; i < 8; ++i) v[i] = acc[ai][bj][m][i >> 2][i & 3];
                    if (mode == 1) {
#pragma unroll
                        for (int i = 0; i < 8; ++i) v[i] = v[i] * sigmoidf_(v[i]);
                    } else if (mode == 2) {
#pragma unroll
                        for (int i = 0; i < 8; ++i) v[i] = __logf(lb[i] + (1.f - lb[i]) * sigmoidf_(v[i]));
                    } else if (mode == 3) {
#pragma unroll
                        for (int i = 0; i < 8; ++i) v[i] = sigmoidf_(v[i]);
                    }
                    u32x4 w; w.x = pk2(v[0], v[1]); w.y = pk2(v[2], v[3]); w.z = pk2(v[4], v[5]); w.w = pk2(v[6], v[7]);
                    *(u32x4*)(base + (size_t)(rbase + ai * 128 + m * 16) * ldc + c0 + bj * 128) = w; }
        }
    }
};

struct EpiMerge {
    const bf16_t* gates; bf16_t* part; bf16_t* merged;
    __device__ __forceinline__ void operator()(AccRef acc, const Unit& u, int wr, int wc, int fr, int fq) const {
        const int j = u.pm >> 8, pm = u.pm & 255, pn = u.pn & 3;
        const int rbase = pm * 256 + wr * 64 + fr, c0 = pn * 256 + wc * 32 + 8 * fq;
#pragma unroll
        for (int ai = 0; ai < 2; ++ai)
#pragma unroll
            for (int m = 0; m < 4; ++m) { const size_t r = (size_t)(rbase + ai * 128 + m * 16);
#pragma unroll
                for (int bj = 0; bj < 2; ++bj) { const int c = c0 + bj * 128;
                    const u32x4 gw = *(const u32x4*)(gates + r * 3072 + j * 1024 + c);
                    f32x4 v0 = acc[ai][bj][m][0], v1 = acc[ai][bj][m][1];
                    v0[0] *= bflo(gw.x); v0[1] *= bfhi(gw.x); v0[2] *= bflo(gw.y); v0[3] *= bfhi(gw.y);
                    v1[0] *= bflo(gw.z); v1[1] *= bfhi(gw.z); v1[2] *= bflo(gw.w); v1[3] *= bfhi(gw.w);
                    if (j == 2) { const u32x4 p0 = *(const u32x4*)(part + r * 1024 + c), p1 = *(const u32x4*)(part + (size_t)MTOK * 1024 + r * 1024 + c);
                        v0[0] += bflo(p0.x) + bflo(p1.x); v0[1] += bfhi(p0.x) + bfhi(p1.x); v0[2] += bflo(p0.y) + bflo(p1.y); v0[3] += bfhi(p0.y) + bfhi(p1.y);
                        v1[0] += bflo(p0.z) + bflo(p1.z); v1[1] += bfhi(p0.z) + bfhi(p1.z); v1[2] += bflo(p0.w) + bflo(p1.w); v1[3] += bfhi(p0.w) + bfhi(p1.w); }
                    u32x4 w; w.x = pk2(v0[0], v0[1]); w.y = pk2(v0[2], v0[3]); w.z = pk2(v1[0], v1[1]); w.w = pk2(v1[2], v1[3]);
                    bf16_t* dst = (j == 2) ? merged : part + (size_t)j * MTOK * 1024;
                    *(u32x4*)(dst + r * 1024 + c) = w; } }
    }
};

struct EpiOut {
    const float* x; bf16_t* x1b; float* rstd; LAS float* rowss; int wv;
    __device__ __forceinline__ void operator()(AccRef acc, const Unit& u, int wr, int wc, int fr, int fq) const {
        const int rloc = wr * 64 + fr, rbase = u.pm * 256 + rloc, c0 = u.pn * 256 + wc * 32 + 8 * fq;
#pragma unroll
        for (int ai = 0; ai < 2; ++ai)
#pragma unroll
            for (int m = 0; m < 4; ++m) { const size_t r = (size_t)(rbase + ai * 128 + m * 16); float sq = 0.f;
#pragma unroll
                for (int bj = 0; bj < 2; ++bj) { const int c = c0 + bj * 128;
                    f32x4 v0 = acc[ai][bj][m][0] + *(const f32x4*)(x + r * 1024 + c), v1 = acc[ai][bj][m][1] + *(const f32x4*)(x + r * 1024 + c + 4);
                    sq += v0[0] * v0[0] + v0[1] * v0[1] + v0[2] * v0[2] + v0[3] * v0[3] + v1[0] * v1[0] + v1[1] * v1[1] + v1[2] * v1[2] + v1[3] * v1[3];
                    u32x4 w; w.x = pk2(v0[0], v0[1]); w.y = pk2(v0[2], v0[3]); w.z = pk2(v1[0], v1[1]); w.w = pk2(v1[2], v1[3]); *(u32x4*)(x1b + r * 1024 + c) = w; }
                sq += sxor<16>(sq); sq += sxor<32>(sq);
                if (fq == 0) { LAS float* sl = rowss + (rloc + ai * 128 + m * 16) * 4 + wc; *sl = (u.pn == 0) ? sq : (*sl + sq); } }
        if (u.pn == 3) {
            asm volatile("s_waitcnt lgkmcnt(0)" ::: "memory");
            __builtin_amdgcn_s_barrier();
            const int t = tid_from(wv);
            if (t < 256) { const f32x4 q = *(const LAS f32x4*)(rowss + t * 4); rstd[u.pm * 256 + t] = __builtin_amdgcn_rsqf(((q[0] + q[1]) + (q[2] + q[3])) * (1.f / 1024.f) + EPS); }
            asm volatile("s_waitcnt lgkmcnt(0)" ::: "memory");
            __builtin_amdgcn_s_barrier();
        }
    }
};

template <int CTRL> __device__ __forceinline__ float dppf(float v) {
    return __builtin_bit_cast(float, __builtin_amdgcn_update_dpp(0, __builtin_bit_cast(int, v), CTRL, 0xf, 0xf, true));
}
struct EpiUp {
    const float* ss; const float* cw; const float* cb; bf16_t* y; LAS float* hal;
    __device__ __forceinline__ void operator()(AccRef acc, const Unit& u, int wr, int wc, int fr, int fq) const {
        const int R0 = 254 * u.pm - 2 + wr * 64 + fr;
        const int chl = wc * 32 + 8 * fq;
        const int gch = u.pn * 128 + chl;
#pragma unroll
        for (int ai = 0; ai < 2; ++ai)
#pragma unroll
            for (int m = 0; m < 4; ++m) { const int R = R0 + ai * 128 + m * 16; float rs = 0.f;
                if (R >= 0 && R < MTOK) rs = ss[R];
#pragma unroll
                for (int bj = 0; bj < 2; ++bj)
#pragma unroll
                    for (int n = 0; n < 2; ++n) acc[ai][bj][m][n] = acc[ai][bj][m][n] * rs; }
        if (fr >= 14) {
#pragma unroll
            for (int ai = 0; ai < 2; ++ai) { LAS float* hp = hal + ((2 * ai + wr) * 2 + (fr - 14)) * 128 + chl;
                *(LAS f32x4*)hp = acc[ai][0][3][0]; *(LAS f32x4*)(hp + 4) = acc[ai][0][3][1]; }
        }
        asm volatile("s_waitcnt lgkmcnt(0)" ::: "memory");
        __builtin_amdgcn_s_barrier();
        f32x4 w0[2], w1[2], w2[2], bb[2];
#pragma unroll
        for (int n = 0; n < 2; ++n) { w0[n] = *(const f32x4*)(cw + gch + 4 * n); w1[n] = *(const f32x4*)(cw + FFD + gch + 4 * n); w2[n] = *(const f32x4*)(cw + 2 * FFD + gch + 4 * n); bb[n] = *(const f32x4*)(cb + gch + 4 * n); }
#pragma unroll
        for (int ai = 0; ai < 2; ++ai) { const int blk = 2 * ai + wr;
            f32x4 H[2]; H[0] = (f32x4){0.f, 0.f, 0.f, 0.f}; H[1] = H[0];
            if (fr >= 14 && blk >= 1) { const LAS float* hp = hal + ((blk - 1) * 2 + (fr - 14)) * 128 + chl; H[0] = *(const LAS f32x4*)hp; H[1] = *(const LAS f32x4*)(hp + 4); }
#pragma unroll
            for (int m = 3; m >= 0; --m) { const int tr = ai * 128 + wr * 64 + m * 16 + fr; const int R = R0 + ai * 128 + m * 16; const int tt = R & 2047;
                float o[8];
#pragma unroll
                for (int n = 0; n < 2; ++n)
#pragma unroll
                    for (int e = 0; e < 4; ++e) { const float xc = acc[ai][0][m][n][e]; const float xp = (m == 0) ? H[n][e] : acc[ai][0][m > 0 ? m - 1 : 0][n][e];
                        const float s1 = dppf<0x111>(xc), r1 = dppf<0x121>(xp), s2 = dppf<0x112>(xc), r2 = dppf<0x122>(xp);
                        float p1 = (fr >= 1) ? s1 : r1, p2 = (fr >= 2) ? s2 : r2;
                        if (tt < 1) p1 = 0.f;
                        if (tt < 2) p2 = 0.f;
                        o[4 * n + e] = w2[n][e] * xc + w1[n][e] * p1 + w0[n][e] * p2 + bb[n][e]; }
                if (tr >= 2 && R < MTOK) {
                    const f32x2 g0 = pg8::gelu_pk((f32x2){o[0], o[1]}), g1 = pg8::gelu_pk((f32x2){o[2], o[3]}), g2 = pg8::gelu_pk((f32x2){o[4], o[5]}), g3 = pg8::gelu_pk((f32x2){o[6], o[7]});
                    const f32x4 v0 = acc[ai][1][m][0], v1 = acc[ai][1][m][1];
                    u32x4 w; w.x = pk2(g0.x * v0[0], g0.y * v0[1]); w.y = pk2(g1.x * v0[2], g1.y * v0[3]); w.z = pk2(g2.x * v1[0], g2.y * v1[1]); w.w = pk2(g3.x * v1[2], g3.y * v1[3]);
                    *(u32x4*)(y + (size_t)R * FFD + gch) = w; } } }
    }
};

struct EpiDown {
    const bf16_t* x1b; float* out;
    __device__ __forceinline__ void operator()(AccRef acc, const Unit& u, int wr, int wc, int fr, int fq) const {
        const int rbase = u.pm * 256 + wr * 64 + fr, c0 = u.pn * 256 + wc * 32 + 8 * fq;
#pragma unroll
        for (int ai = 0; ai < 2; ++ai)
#pragma unroll
            for (int m = 0; m < 4; ++m) { const size_t r = (size_t)(rbase + ai * 128 + m * 16);
#pragma unroll
                for (int bj = 0; bj < 2; ++bj) { const size_t o = r * 1024 + c0 + bj * 128; const u32x4 xw = *(const u32x4*)(x1b + o);
                    f32x4 v0 = acc[ai][bj][m][0], v1 = acc[ai][bj][m][1];
                    v0[0] += bflo(xw.x); v0[1] += bfhi(xw.x); v0[2] += bflo(xw.y); v0[3] += bfhi(xw.y); v1[0] += bflo(xw.z); v1[1] += bfhi(xw.z); v1[2] += bflo(xw.w); v1[3] += bfhi(xw.w);
                    *(f32x4*)(out + o) = v0; *(f32x4*)(out + o + 4) = v1; } }
    }
};

__device__ __forceinline__ void transpose_item(const float* W, int ldw, int K, bf16_t* WT, int n0, int sc0, int k0, const float* ksc, LAS float* scr, int lane) {
#pragma unroll
    for (int i = 0; i < 32; ++i) { const int kk = 2 * i + (lane >> 5); float w = W[(size_t)(k0 + kk) * ldw + sc0 + (lane & 31)]; if (ksc) w *= ksc[k0 + kk]; scr[kk * 33 + (lane & 31)] = w; }
    asm volatile("s_waitcnt lgkmcnt(0)" ::: "memory");
    const int c = lane & 7;
#pragma unroll
    for (int j = 0; j < 4; ++j) { const int n = (lane >> 3) + 8 * j; const LAS float* s = scr + (8 * c) * 33 + n;
        u32x4 o; o.x = pk2(s[0 * 33], s[1 * 33]); o.y = pk2(s[2 * 33], s[3 * 33]); o.z = pk2(s[4 * 33], s[5 * 33]); o.w = pk2(s[6 * 33], s[7 * 33]);
        *(u32x4*)(WT + (size_t)(n0 + n) * K + k0 + 8 * c) = o; }
    asm volatile("s_waitcnt lgkmcnt(0)" ::: "memory");
}

struct Params {
    const float* in[22]; float* out; unsigned char* ws;
};

template <bool FF> __device__ __forceinline__ void norm_rows(const float* xbase, int nrows, int gw, int NGW, const float* g, bf16_t* obase, const LAS float* ffw, const float* fbias, float* flog, int lane) {
    f32x4 gr[4];
#pragma unroll
    for (int j = 0; j < 4; ++j) gr[j] = ((const f32x4*)g)[lane + 64 * j];
    f32x4 nv[2][4];
#pragma unroll
    for (int r = 0; r < 2; ++r) { const int m = gw + r * NGW; const int mc = m < nrows ? m : nrows - 1;
#pragma unroll
        for (int j = 0; j < 4; ++j) nv[r][j] = ((const f32x4*)(xbase + (size_t)mc * DM))[lane + 64 * j]; }
    for (int m0 = gw; m0 < nrows; m0 += 2 * NGW) {
        f32x4 v[2][4]; float s[2];
#pragma unroll
        for (int r = 0; r < 2; ++r) { s[r] = 0.f;
#pragma unroll
            for (int j = 0; j < 4; ++j) { v[r][j] = nv[r][j]; s[r] += (v[r][j][0] * v[r][j][0] + v[r][j][1] * v[r][j][1]) + (v[r][j][2] * v[r][j][2] + v[r][j][3] * v[r][j][3]); } }
#pragma unroll
        for (int r = 0; r < 2; ++r) { const int m = m0 + (2 + r) * NGW; const int mc = m < nrows ? m : nrows - 1;
#pragma unroll
            for (int j = 0; j < 4; ++j) nv[r][j] = ((const f32x4*)(xbase + (size_t)mc * DM))[lane + 64 * j]; }
        s[0] = xsum64(s[0]); s[1] = xsum64(s[1]);
        float dd[2][8];
#pragma unroll
        for (int r = 0; r < 2; ++r) { const int m = m0 + r * NGW; const bool ok = m < nrows;
            const float rstd = __builtin_amdgcn_rsqf(s[r] * (1.f / DM) + EPS);
#pragma unroll
            for (int j = 0; j < 4; ++j) v[r][j] = v[r][j] * rstd * gr[j];
            if (ok) { u32x2* o8 = (u32x2*)(obase + (size_t)m * DM) + lane;
#pragma unroll
                for (int j = 0; j < 4; ++j) { u32x2 w; w.x = pk2(v[r][j][0], v[r][j][1]); w.y = pk2(v[r][j][2], v[r][j][3]); o8[64 * j] = w; } } }
        if (FF) {
#pragma unroll
            for (int jj = 0; jj < 8; ++jj) { float t0 = 0.f, t1 = 0.f;
#pragma unroll
                for (int j = 0; j < 4; ++j) { const f32x4 w = *(const LAS f32x4*)(ffw + jj * 1024 + 4 * (lane + 64 * j));
                    t0 += v[0][j][0] * w[0] + v[0][j][1] * w[1] + v[0][j][2] * w[2] + v[0][j][3] * w[3]; t1 += v[1][j][0] * w[0] + v[1][j][1] * w[1] + v[1][j][2] * w[2] + v[1][j][3] * w[3]; }
                dd[0][jj] = t0; dd[1][jj] = t1; }
            const bool b5 = (lane & 32) != 0, b4 = (lane & 16) != 0, b3 = (lane & 8) != 0;
            float rr[2];
#pragma unroll
            for (int r = 0; r < 2; ++r) { float k4[4], k2[2];
#pragma unroll
                for (int j = 0; j < 4; ++j) { const float snd = b5 ? dd[r][j] : dd[r][j + 4], kp = b5 ? dd[r][j + 4] : dd[r][j]; k4[j] = kp + sxor<32>(snd); }
#pragma unroll
                for (int j = 0; j < 2; ++j) { const float snd = b4 ? k4[j] : k4[j + 2], kp = b4 ? k4[j + 2] : k4[j]; k2[j] = kp + sxor<16>(snd); }
                { const float snd = b3 ? k2[0] : k2[1], kp = b3 ? k2[1] : k2[0]; rr[r] = kp + sxor<8>(snd); }
                rr[r] += sxor<4>(rr[r]); rr[r] += sxor<2>(rr[r]); rr[r] += sxor<1>(rr[r]); }
            if ((lane & 7) == 0) { const int jj = lane >> 3;
#pragma unroll
                for (int r = 0; r < 2; ++r) { const int m = m0 + r * NGW; if (m < nrows) { const float zz = rr[r] + fbias[jj]; flog[(size_t)m * 8 + jj] = fminf(zz, 0.f) - log1pf(__expf(-fabsf(zz))); } } }
        }
    }
}

typedef float f32x16 __attribute__((ext_vector_type(16)));
__device__ __forceinline__ float swapmax(float v) { auto rr = __builtin_amdgcn_permlane32_swap(__float_as_uint(v), __float_as_uint(v), false, false); const unsigned a = rr[0], b = rr[1]; return fmaxf(__uint_as_float(a), __uint_as_float(b)); }
__device__ __forceinline__ float swapsum(float v) { auto rr = __builtin_amdgcn_permlane32_swap(__float_as_uint(v), __float_as_uint(v), false, false); const unsigned a = rr[0], b = rr[1]; return __uint_as_float(a) + __uint_as_float(b); }
template <int D, bool FOX, int KS, int VS>
__device__ __forceinline__ void attn_tile(const LAS bf16_t* Ks, const LAS bf16_t* Vs, const bf16x8 (&qf)[D / 16], const bf16x8 qx, f32x16 (&O)[D / 32], float& mrow, float& lrow,
                                          int k0, int q0w, int r32, int hi) {
    f32x16 s[2];
#pragma unroll
    for (int kb = 0; kb < 2; ++kb) {
#pragma unroll
        for (int j = 0; j < 16; ++j) s[kb][j] = 0.f;
#pragma unroll
        for (int ks = 0; ks < D / 16; ++ks) { const bf16x8 kf = *(const LAS bf16x8*)(Ks + (32 * kb + r32) * KS + 16 * ks + 8 * hi);
            s[kb] = __builtin_amdgcn_mfma_f32_32x32x16_bf16(kf, qf[ks], s[kb], 0, 0, 0); }
        if (FOX) {
            const bf16x8 kx = *(const LAS bf16x8*)(Ks + (32 * kb + r32) * KS + D + 8 * hi);
            s[kb] = __builtin_amdgcn_mfma_f32_32x32x16_bf16(kx, qx, s[kb], 0, 0, 0); } }
    if (FOX) {
        if (k0 + 63 > q0w) {
#pragma unroll
            for (int kb = 0; kb < 2; ++kb)
#pragma unroll
                for (int j = 0; j < 16; ++j) { const int key = k0 + 32 * kb + 8 * (j >> 2) + 4 * hi + (j & 3); if (key > q0w + r32) s[kb][j] = -1e30f; }
        }
    }
    float mx = fmaxf(s[0][0], s[1][0]);
#pragma unroll
    for (int j = 1; j < 16; ++j) mx = fmaxf(mx, fmaxf(s[0][j], s[1][j]));
    mx = swapmax(mx);
    if (__builtin_amdgcn_ballot_w64(mx > mrow) != 0ull) {
        const float mn = fmaxf(mrow, mx); const float al = __builtin_amdgcn_exp2f(mrow - mn); mrow = mn;
        lrow = lrow * al;
#pragma unroll
        for (int i = 0; i < D / 32; ++i) O[i] = O[i] * al;
    }
    const float mn = mrow;
    float ps = 0.f;
#pragma unroll
    for (int kb = 0; kb < 2; ++kb)
#pragma unroll
        for (int j = 0; j < 16; ++j) { const float p = __builtin_amdgcn_exp2f(s[kb][j] - mn); s[kb][j] = p; ps += p; }
    lrow += ps;
#pragma unroll
    for (int kb = 0; kb < 2; ++kb)
#pragma unroll
        for (int sx = 0; sx < 2; ++sx) { u32x4 pw; pw.x = pk2(s[kb][8 * sx + 0], s[kb][8 * sx + 1]); pw.y = pk2(s[kb][8 * sx + 2], s[kb][8 * sx + 3]); pw.z = pk2(s[kb][8 * sx + 4], s[kb][8 * sx + 5]); pw.w = pk2(s[kb][8 * sx + 6], s[kb][8 * sx + 7]);
            const bf16x8 pf = __builtin_bit_cast(bf16x8, pw);
#pragma unroll
            for (int db = 0; db < D / 32; ++db) { const LAS bf16_t* vp = Vs + (32 * db + r32) * VS + 32 * kb + 16 * sx + 4 * hi;
                const u32x2 lo = *(const LAS u32x2*)vp, hi2 = *(const LAS u32x2*)(vp + 8); const u32x4 vw = {lo.x, lo.y, hi2.x, hi2.y};
                O[db] = __builtin_amdgcn_mfma_f32_32x32x16_bf16(__builtin_bit_cast(bf16x8, vw), pf, O[db], 0, 0, 0); } }
}
template <int D> __device__ __forceinline__ void q_frags(const u32x4 (&qw)[D / 16], const float* qg, float scale, int hi, bf16x8 (&qf)[D / 16]) {
    float ssq = 0.f;
#pragma unroll
    for (int ks = 0; ks < D / 16; ++ks) { const float t0 = bflo(qw[ks].x), t1 = bfhi(qw[ks].x), t2 = bflo(qw[ks].y), t3 = bfhi(qw[ks].y), t4 = bflo(qw[ks].z), t5 = bfhi(qw[ks].z), t6 = bflo(qw[ks].w), t7 = bfhi(qw[ks].w);
        ssq += (t0 * t0 + t1 * t1) + (t2 * t2 + t3 * t3) + (t4 * t4 + t5 * t5) + (t6 * t6 + t7 * t7); }
    ssq = swapsum(ssq);
    const float rs = scale * __builtin_amdgcn_rsqf(ssq * (1.f / D) + EPS);
#pragma unroll
    for (int ks = 0; ks < D / 16; ++ks) { const f32x4 g0 = *(const f32x4*)(qg + 16 * ks + 8 * hi), g1 = *(const f32x4*)(qg + 16 * ks + 8 * hi + 4); u32x4 w;
        w.x = pk2(bflo(qw[ks].x) * rs * g0[0], bfhi(qw[ks].x) * rs * g0[1]); w.y = pk2(bflo(qw[ks].y) * rs * g0[2], bfhi(qw[ks].y) * rs * g0[3]);
        w.z = pk2(bflo(qw[ks].z) * rs * g1[0], bfhi(qw[ks].z) * rs * g1[1]); w.w = pk2(bflo(qw[ks].w) * rs * g1[2], bfhi(qw[ks].w) * rs * g1[3]); qf[ks] = __builtin_bit_cast(bf16x8, w); }
}
template <int D> __device__ __forceinline__ void o_store(const f32x16 (&O)[D / 32], float lrow, bf16_t* orow, int hi) {
    const float linv = __builtin_amdgcn_rcpf(swapsum(lrow));
#pragma unroll
    for (int db = 0; db < D / 32; ++db)
#pragma unroll
        for (int g4 = 0; g4 < 4; g4 += 2) {
            unsigned ax = pk2(O[db][4 * g4] * linv, O[db][4 * g4 + 1] * linv), ay = pk2(O[db][4 * g4 + 2] * linv, O[db][4 * g4 + 3] * linv);
            unsigned bx = pk2(O[db][4 * g4 + 4] * linv, O[db][4 * g4 + 5] * linv), by = pk2(O[db][4 * g4 + 6] * linv, O[db][4 * g4 + 7] * linv);
            { auto r = __builtin_amdgcn_permlane32_swap(ax, bx, false, false); const unsigned r0 = r[0], r1 = r[1]; ax = r0; bx = r1; }
            { auto r = __builtin_amdgcn_permlane32_swap(ay, by, false, false); const unsigned r0 = r[0], r1 = r[1]; ay = r0; by = r1; }
            *(u32x4*)(orow + 32 * db + 8 * g4 + (hi ? 8 : 0)) = (u32x4){ax, ay, bx, by}; }
}
__device__ __forceinline__ void o_store_lds64(const f32x16 (&O)[2], float lrow, bf16_t* obase  , int ldo, LAS bf16_t* stg, int r32, int hi, int lane) {
    constexpr int SS_ = 72;
    const float linv = __builtin_amdgcn_rcpf(swapsum(lrow));
#pragma unroll
    for (int db = 0; db < 2; ++db)
#pragma unroll
        for (int g4 = 0; g4 < 4; ++g4) { u32x2 w; w.x = pk2(O[db][4 * g4] * linv, O[db][4 * g4 + 1] * linv); w.y = pk2(O[db][4 * g4 + 2] * linv, O[db][4 * g4 + 3] * linv);
            *(LAS u32x2*)(stg + r32 * SS_ + 32 * db + 8 * g4 + 4 * hi) = w; }
    asm volatile("s_waitcnt lgkmcnt(0)" ::: "memory");
#pragma unroll
    for (int i = 0; i < 4; ++i) { const int row = (lane >> 3) + 8 * i, ch = lane & 7; const u32x4 v = *(const LAS u32x4*)(stg + row * SS_ + 8 * ch);
        *(u32x4*)(obase + (size_t)row * ldo + 8 * ch) = v; }
}

template <int D> __device__ __forceinline__ u32x4 knorm_chunk(const u32x4 w, const float (&kgr)[8]) {
    constexpr int NKC = D / 8; float t[8];
    t[0] = bflo(w.x); t[1] = bfhi(w.x); t[2] = bflo(w.y); t[3] = bfhi(w.y); t[4] = bflo(w.z); t[5] = bfhi(w.z); t[6] = bflo(w.w); t[7] = bfhi(w.w);
    float sq = (t[0] * t[0] + t[1] * t[1]) + (t[2] * t[2] + t[3] * t[3]) + (t[4] * t[4] + t[5] * t[5]) + (t[6] * t[6] + t[7] * t[7]);
    sq += sxor<1>(sq); sq += sxor<2>(sq); sq += sxor<4>(sq); if (NKC == 16) sq += sxor<8>(sq);
    const float rs = __builtin_amdgcn_rsqf(sq * (1.f / D) + EPS);
    u32x4 o4; o4.x = pk2(t[0] * rs * kgr[0], t[1] * rs * kgr[1]); o4.y = pk2(t[2] * rs * kgr[2], t[3] * rs * kgr[3]); o4.z = pk2(t[4] * rs * kgr[4], t[5] * rs * kgr[5]); o4.w = pk2(t[6] * rs * kgr[6], t[7] * rs * kgr[7]);
    return o4;
}

__device__ __forceinline__ void fox_unit(LAS unsigned char* lds, const bf16_t* Qp, const bf16_t* Kp, const bf16_t* Vt, const float* qg, const float* kg, const float* Fc, int q0, int nkt, const int* ktab, bf16_t* Op, const int wv) {
    constexpr int D = 64, KS = D + 16 + 8, VS = 72, ldq = 512, ldk = 512, ldvt = 2048, ldo = 512, NB = 5;
    constexpr int BUFB = 64 * KS * 2 + D * VS * 2;
    constexpr float L2E = 1.4426950408889634f;
    const int tid = tid_from(wv);
    const int wid = wv, lane = tid & 63, r32 = lane & 31, hi = lane >> 5;
    const int q0w = q0 + wid * 32, tq = q0 >> 6, dw = tq + (wid >> 1);
    const int kt0 = __builtin_amdgcn_readfirstlane(ktab[q0 >> 5]), ktw = __builtin_amdgcn_readfirstlane(ktab[q0w >> 5]);
    int nsteps = 0;
#pragma unroll
    for (int w = 0; w < 8; ++w) { const int n = tq + (w >> 1) - __builtin_amdgcn_readfirstlane(ktab[(q0 >> 5) + w]) + 1; nsteps = n > nsteps ? n : nsteps; }
    bf16x8 qf[4];
    { const bf16_t* qrow = Qp + (size_t)(q0w + r32) * ldq + 8 * hi;
#pragma unroll
      for (int ks = 0; ks < 4; ++ks) qf[ks] = *(const bf16x8*)(qrow + 16 * ks); }
    bf16x8 qx;
    { const float F = Fc[q0w + r32] * L2E; const unsigned c1 = f2bf(F); const float r1 = F - bf1((bf16_t)c1); const unsigned c2 = f2bf(r1); const float r2 = r1 - bf1((bf16_t)c2); const unsigned c3 = f2bf(r2);
      u32x4 w = {c1 | (c2 << 16), c3 | (0x3f80u << 16), 0x3f80u | (0x3f80u << 16), 0u}; if (hi) w = (u32x4){0u, 0u, 0u, 0u}; qx = __builtin_bit_cast(bf16x8, w); }
    f32x16 O[2];
#pragma unroll
    for (int i = 0; i < 2; ++i)
#pragma unroll
        for (int j = 0; j < 16; ++j) O[i][j] = 0.f;
    float mrow = -1e30f, lrow = 0.f;
    const int key = tid >> 3, dc = tid & 7;
#define FOX_LOAD(kr, vr, fr_, kt) do { kr = *(const u32x4*)(Kp + (size_t)((kt) * 64 + key) * ldk + 8 * dc); vr = *(const u32x4*)(Vt + (size_t)key * ldvt + (kt) * 64 + 8 * dc); \
        if (tid < 64) fr_ = Fc[(kt) * 64 + tid] * L2E; } while (0)
#define FOX_STAGE(kr, vr, fr_, kt) do { LAS bf16_t* Ks_ = (LAS bf16_t*)(lds + ((kt) % NB) * BUFB); LAS bf16_t* Vs_ = Ks_ + 64 * KS; \
        *(LAS u32x4*)(Ks_ + key * KS + 8 * dc) = kr; *(LAS u32x4*)(Vs_ + key * VS + 8 * dc) = vr; \
        if (tid < 64) { const float F = fr_; const unsigned c1 = f2bf(F); const float r1 = F - bf1((bf16_t)c1); const unsigned c2 = f2bf(r1); const float r2 = r1 - bf1((bf16_t)c2); const unsigned c3 = f2bf(r2); \
            *(LAS u32x4*)(Ks_ + tid * KS + D) = (u32x4){0x3f80u | (0x3f80u << 16), 0x3f80u | ((c1 ^ 0x8000u) << 16), (c2 ^ 0x8000u) | ((c3 ^ 0x8000u) << 16), 0u}; \
            *(LAS u32x4*)(Ks_ + tid * KS + D + 8) = (u32x4){0u, 0u, 0u, 0u}; } } while (0)
    {
        u32x4 k4[4], v4[4]; float f4[4] = {0.f, 0.f, 0.f, 0.f};
#pragma unroll
        for (int j = 0; j < 4; ++j) FOX_LOAD(k4[j], v4[j], f4[j], tq + 3 - j);
#pragma unroll
        for (int j = 0; j < 4; ++j) FOX_STAGE(k4[j], v4[j], f4[j], tq + 3 - j);
    }
    u32x4 kreg, vreg; float fkreg = 0.f;
    if (tq - 1 >= kt0) FOX_LOAD(kreg, vreg, fkreg, tq - 1);
    __syncthreads();
    for (int i = 0; i < nsteps; ++i) {
        const int tl = tq - 1 - i;
        if (tl >= kt0) { FOX_STAGE(kreg, vreg, fkreg, tl); if (tl - 1 >= kt0) FOX_LOAD(kreg, vreg, fkreg, tl - 1); }
        const int t = dw - i;
        if (t >= ktw) {
            const LAS bf16_t* Ks = (const LAS bf16_t*)(lds + (t % NB) * BUFB); const LAS bf16_t* Vs = Ks + 64 * KS;
            attn_tile<64, true, KS, VS>(Ks, Vs, qf, qx, O, mrow, lrow, t * 64, q0w, r32, hi);
        }
        __syncthreads();
    }
#undef FOX_LOAD
#undef FOX_STAGE
    o_store_lds64(O, lrow, Op + (size_t)q0w * ldo, ldo, (LAS bf16_t*)(lds + wid * 4608), r32, hi, lane);
}

__device__ __forceinline__ void mem_unit(LAS unsigned char* lds, const bf16_t* Qp, const bf16_t* Kp, const bf16_t* Vt, const float* qg, const float* kg, bf16_t* Op, const int wv) {
    constexpr int D = 128, KS = D + 8, VS = 264, ldq = 512, ldk = 512, ldvt = 256, ldo = 512;
    constexpr float L2E = 1.4426950408889634f;
    const int tid = tid_from(wv);
    const int wid = wv, lane = tid & 63, r32 = lane & 31, hi = lane >> 5;
    LAS bf16_t* Ks = (LAS bf16_t*)lds; LAS bf16_t* Vs = Ks + 256 * KS;
    bf16x8 qw[8];
    { const bf16_t* qrow = Qp + (size_t)(wid * 32 + r32) * ldq + 8 * hi;
#pragma unroll
      for (int ks = 0; ks < 8; ++ks) qw[ks] = *(const bf16x8*)(qrow + 16 * ks); }
    {
#pragma unroll
      for (int rnd = 0; rnd < 2; ++rnd) { u32x4 kr[4], vr[4];
#pragma unroll
          for (int i = 0; i < 4; ++i) { const int ci = tid + 512 * (4 * rnd + i); const int key = ci >> 4, dc = ci & 15; kr[i] = *(const u32x4*)(Kp + (size_t)key * ldk + 8 * dc);
              const int d = ci >> 5, kc = ci & 31; vr[i] = *(const u32x4*)(Vt + (size_t)d * ldvt + 8 * kc); }
#pragma unroll
          for (int i = 0; i < 4; ++i) { const int ci = tid + 512 * (4 * rnd + i); const int key = ci >> 4, dc = ci & 15; *(LAS u32x4*)(Ks + key * KS + 8 * dc) = kr[i];
              const int d = ci >> 5, kc = ci & 31; *(LAS u32x4*)(Vs + d * VS + 8 * kc) = vr[i]; } } }
    __syncthreads();
    for (int qb = 0; qb < 4; ++qb) {
        bf16x8 qf[8];
#pragma unroll
        for (int ks = 0; ks < 8; ++ks) qf[ks] = qw[ks];
        if (qb + 1 < 4) { const bf16_t* qrow = Qp + (size_t)((qb + 1) * 256 + wid * 32 + r32) * ldq + 8 * hi;
#pragma unroll
            for (int ks = 0; ks < 8; ++ks) qw[ks] = *(const bf16x8*)(qrow + 16 * ks); }
        f32x16 O[4];
#pragma unroll
        for (int i = 0; i < 4; ++i)
#pragma unroll
            for (int j = 0; j < 16; ++j) O[i][j] = 0.f;
        float mrow = -1e30f, lrow = 0.f;
#pragma unroll 2
        for (int kt = 0; kt < 4; ++kt) attn_tile<128, false, KS, VS>(Ks + kt * 64 * KS, Vs + kt * 64, qf, qf[0], O, mrow, lrow, 0, 0, r32, hi);
        o_store<128>(O, lrow, Op + (size_t)(qb * 256 + wid * 32 + r32) * ldo, hi);
    }
    __syncthreads();
}

__device__ __forceinline__ void hgrn_unit(LAS unsigned char* lds, const bf16_t* hq, const bf16_t* hlf, const bf16_t* hi, const bf16_t* hg, const float* ng, bf16_t* ya, int b, int h, const int wv) {
    constexpr int QS = 136, TS = 72, OS = 132;
    LAS bf16_t* QD = (LAS bf16_t*)lds;
    LAS bf16_t* KD = QD + 64 * QS;
    LAS bf16_t* KDT = KD + 64 * QS;
    LAS bf16_t* IT = KDT + 128 * TS;
    LAS bf16_t* AM = IT + 128 * TS;
    LAS float* DV = (LAS float*)(AM + 64 * TS);
    LAS float* SEG = DV + 128;
    LAS float* OB = SEG + 512;
    const int tid = tid_from(wv);
    const int wid = wv, lane = tid & 63, fr = lane & 15, g = lane >> 4;
    const int c = tid & 127, sg = tid >> 7;
    const size_t rowbase = (size_t)b * NT;
    const size_t cbase = rowbase * 512 + h * 128 + c;
    f32x4 S[8];
#pragma unroll
    for (int i = 0; i < 8; ++i) S[i] = (f32x4){0.f, 0.f, 0.f, 0.f};
    bf16_t rq[16], rf[16], ri[16];
#pragma unroll
    for (int tt = 0; tt < 16; ++tt) { const size_t o = cbase + (size_t)(sg * 16 + tt) * 512; rq[tt] = hq[o]; rf[tt] = hlf[o]; ri[tt] = hi[o]; }
    for (int ch = 0; ch < NT / 64; ++ch) {
        float Gl[16]; float run = 0.f;
#pragma unroll
        for (int tt = 0; tt < 16; ++tt) { run += bf1(rf[tt]); Gl[tt] = run; }
        SEG[sg * 128 + c] = run;
        __syncthreads();
        float pre = 0.f, tot = 0.f;
#pragma unroll
        for (int s4 = 0; s4 < 4; ++s4) { const float v = SEG[s4 * 128 + c]; tot += v; if (s4 < sg) pre += v; }
        if (sg == 0) DV[c] = __expf(tot);
        unsigned kp[8], ip[8];
#pragma unroll
        for (int tt = 0; tt < 16; ++tt) { const float G = pre + Gl[tt]; const float qd = bf1(rq[tt]) * __expf(G); const float kd = (1.f - __expf(bf1(rf[tt]))) * __expf(-G);
            const unsigned qb = f2bf_hw(qd), kb = f2bf_hw(kd);
            QD[(16 * sg + tt) * QS + c] = (bf16_t)qb; KD[(16 * sg + tt) * QS + c] = (bf16_t)kb;
            if (tt & 1) { kp[tt >> 1] |= kb << 16; ip[tt >> 1] |= (unsigned)ri[tt] << 16; } else { kp[tt >> 1] = kb; ip[tt >> 1] = (unsigned)ri[tt]; } }
        *(LAS u32x4*)(KDT + c * TS + 16 * sg) = (u32x4){kp[0], kp[1], kp[2], kp[3]}; *(LAS u32x4*)(KDT + c * TS + 16 * sg + 8) = (u32x4){kp[4], kp[5], kp[6], kp[7]};
        *(LAS u32x4*)(IT + c * TS + 16 * sg) = (u32x4){ip[0], ip[1], ip[2], ip[3]}; *(LAS u32x4*)(IT + c * TS + 16 * sg + 8) = (u32x4){ip[4], ip[5], ip[6], ip[7]};
        if (ch + 1 < NT / 64) {
#pragma unroll
            for (int tt = 0; tt < 16; ++tt) { const size_t o = cbase + (size_t)((ch + 1) * 64 + sg * 16 + tt) * 512; rq[tt] = hq[o]; rf[tt] = hlf[o]; ri[tt] = hi[o]; }
        }
        __syncthreads();
        const size_t goff = (rowbase + ch * 64 + (tid >> 3)) * 512 + h * 128 + 16 * (tid & 7);
        const u32x4 g0 = *(const u32x4*)(hg + goff), g1 = *(const u32x4*)(hg + goff + 8);
#pragma unroll
        for (int bi = 0; bi < 2; ++bi) { const int idx = 2 * wid + bi, tb = idx >> 2, sb = idx & 3;
            f32x4 a = (f32x4){0.f, 0.f, 0.f, 0.f};
            if (sb <= tb) {
#pragma unroll
                for (int ks = 0; ks < 4; ++ks) { const bf16x8 qa = *(const LAS bf16x8*)(QD + (16 * tb + fr) * QS + 32 * ks + 8 * g); const bf16x8 kb = *(const LAS bf16x8*)(KD + (16 * sb + fr) * QS + 32 * ks + 8 * g);
                    a = __builtin_amdgcn_mfma_f32_16x16x32_bf16(qa, kb, a, 0, 0, 0); }
            }
#pragma unroll
            for (int e = 0; e < 4; ++e) { const int t = 16 * tb + 4 * g + e, sx = 16 * sb + fr; AM[t * TS + sx] = (bf16_t)f2bf_hw((sx <= t) ? a[e] : 0.f); } }
        __syncthreads();
        bf16x8 itf[2];
#pragma unroll
        for (int k2 = 0; k2 < 2; ++k2) itf[k2] = *(const LAS bf16x8*)(IT + (16 * wid + fr) * TS + 32 * k2 + 8 * g);
        bf16x8 sbf[4];
#pragma unroll
        for (int m4 = 0; m4 < 4; ++m4) { u32x4 w; w.x = pk2(S[2 * m4][0], S[2 * m4][1]); w.y = pk2(S[2 * m4][2], S[2 * m4][3]); w.z = pk2(S[2 * m4 + 1][0], S[2 * m4 + 1][1]); w.w = pk2(S[2 * m4 + 1][2], S[2 * m4 + 1][3]); sbf[m4] = __builtin_bit_cast(bf16x8, w); }
#pragma unroll
        for (int tb = 0; tb < 4; ++tb) { f32x4 O = (f32x4){0.f, 0.f, 0.f, 0.f};
#pragma unroll
            for (int k2 = 0; k2 < 2; ++k2) { const bf16x8 am = *(const LAS bf16x8*)(AM + (16 * tb + fr) * TS + 32 * k2 + 8 * g); O = __builtin_amdgcn_mfma_f32_16x16x32_bf16(am, itf[k2], O, 0, 0, 0); }
#pragma unroll
            for (int m4 = 0; m4 < 4; ++m4) { const u32x2 lo = *(const LAS u32x2*)(QD + (16 * tb + fr) * QS + 32 * m4 + 4 * g), hi2 = *(const LAS u32x2*)(QD + (16 * tb + fr) * QS + 32 * m4 + 16 + 4 * g);
                const u32x4 w = {lo.x, lo.y, hi2.x, hi2.y}; O = __builtin_amdgcn_mfma_f32_16x16x32_bf16(__builtin_bit_cast(bf16x8, w), sbf[m4], O, 0, 0, 0); }
#pragma unroll
            for (int e = 0; e < 4; ++e) OB[(16 * tb + 4 * g + e) * OS + 16 * wid + fr] = O[e]; }
#pragma unroll
        for (int blk = 0; blk < 8; ++blk) {
#pragma unroll
            for (int k2 = 0; k2 < 2; ++k2) { const bf16x8 kt = *(const LAS bf16x8*)(KDT + (16 * blk + fr) * TS + 32 * k2 + 8 * g); S[blk] = __builtin_amdgcn_mfma_f32_16x16x32_bf16(kt, itf[k2], S[blk], 0, 0, 0); }
            const f32x4 dvv = *(const LAS f32x4*)(DV + 16 * blk + 4 * g); S[blk] = S[blk] * dvv; }
        __syncthreads();
        { const int t = tid >> 3, part = tid & 7; const LAS float* op = OB + t * OS + 16 * part;
            const f32x4 o0 = *(const LAS f32x4*)op, o1 = *(const LAS f32x4*)(op + 4), o2 = *(const LAS f32x4*)(op + 8), o3 = *(const LAS f32x4*)(op + 12);
            float sq = (o0[0] * o0[0] + o0[1] * o0[1] + o0[2] * o0[2] + o0[3] * o0[3]) + (o1[0] * o1[0] + o1[1] * o1[1] + o1[2] * o1[2] + o1[3] * o1[3])
                     + (o2[0] * o2[0] + o2[1] * o2[1] + o2[2] * o2[2] + o2[3] * o2[3]) + (o3[0] * o3[0] + o3[1] * o3[1] + o3[2] * o3[2] + o3[3] * o3[3]);
            sq += sxor<1>(sq); sq += sxor<2>(sq); sq += sxor<4>(sq);
            const float rs = __builtin_amdgcn_rsqf(sq * (1.f / 128.f) + EPS);
            const size_t off = (rowbase + ch * 64 + t) * 512 + h * 128 + 16 * part;
            const f32x4 n0 = *(const f32x4*)(ng + 16 * part), n1 = *(const f32x4*)(ng + 16 * part + 4), n2 = *(const f32x4*)(ng + 16 * part + 8), n3 = *(const f32x4*)(ng + 16 * part + 12);
            u32x4 w0, w1;
            w0.x = pk2(o0[0] * rs * n0[0] * bflo(g0.x), o0[1] * rs * n0[1] * bfhi(g0.x)); w0.y = pk2(o0[2] * rs * n0[2] * bflo(g0.y), o0[3] * rs * n0[3] * bfhi(g0.y));
            w0.z = pk2(o1[0] * rs * n1[0] * bflo(g0.z), o1[1] * rs * n1[1] * bfhi(g0.z)); w0.w = pk2(o1[2] * rs * n1[2] * bflo(g0.w), o1[3] * rs * n1[3] * bfhi(g0.w));
            w1.x = pk2(o2[0] * rs * n2[0] * bflo(g1.x), o2[1] * rs * n2[1] * bfhi(g1.x)); w1.y = pk2(o2[2] * rs * n2[2] * bflo(g1.y), o2[3] * rs * n2[3] * bfhi(g1.y));
            w1.z = pk2(o3[0] * rs * n3[0] * bflo(g1.z), o3[1] * rs * n3[1] * bfhi(g1.z)); w1.w = pk2(o3[2] * rs * n3[2] * bflo(g1.w), o3[3] * rs * n3[3] * bfhi(g1.w));
            *(u32x4*)(ya + off) = w0; *(u32x4*)(ya + off + 8) = w1; }
    }
    __syncthreads();
}

__device__ __forceinline__ void grid_bar(unsigned* cnt, unsigned target, const int wv) {
    __syncthreads();
    if (tid_from(wv) == 0) {
        __builtin_amdgcn_fence(__ATOMIC_RELEASE, "agent");
        __hip_atomic_fetch_add(cnt, 1u, __ATOMIC_RELAXED, __HIP_MEMORY_SCOPE_AGENT);
        while (__hip_atomic_load(cnt, __ATOMIC_RELAXED, __HIP_MEMORY_SCOPE_AGENT) < target) __builtin_amdgcn_s_sleep(1);
        __builtin_amdgcn_fence(__ATOMIC_ACQUIRE, "agent");
    }
    __syncthreads();
}

__global__ void __launch_bounds__(512, 2) fwd_mega(Params P) {
    extern __shared__ __attribute__((aligned(16))) unsigned char lds_raw[];
    LAS unsigned char* lds = (LAS unsigned char*)lds_raw;
    cg::grid_group grid = cg::this_grid();
    const int wv = __builtin_amdgcn_readfirstlane((int)threadIdx.x >> 6);
#define tid (tid_from(wv))
#define lane (lane_id())
#define wid wv
    const int G = gridDim.x, bx = blockIdx.x;
#define ws (P.ws)
#define x (P.in[0])
#define mem (P.in[1])
#define norm_mix_g (P.in[2])
#define norm_mem_g (P.in[3])
#define w_in (P.in[4])
#define lb_logits (P.in[5])
#define hgrn_norm_g (P.in[6])
#define fox_f_bias (P.in[7])
#define fox_q_g (P.in[8])
#define fox_k_g (P.in[9])
#define mem_kv_w (P.in[10])
#define mem_q_g (P.in[11])
#define mem_k_g (P.in[12])
#define w_br_h (P.in[13])
#define w_br_f (P.in[14])
#define w_br_m (P.in[15])
#define w_out (P.in[16])
#define norm_ffn_g (P.in[17])
#define w_up (P.in[18])
#define conv_w (P.in[19])
#define conv_b (P.in[20])
#define w_down (P.in[21])
#define out (P.out)
#define ctl ((unsigned*)(ws + WS_CTL * MiB))
#define WCAT ((bf16_t*)(ws + WS_WCAT * MiB))
#define WBR ((bf16_t*)(ws + WS_WBR * MiB))
#define WOUT ((bf16_t*)(ws + WS_WOUT * MiB))
#define WUP ((bf16_t*)(ws + WS_WUP * MiB))
#define WDOWN ((bf16_t*)(ws + WS_WDOWN * MiB))
#define FLOG ((float*)(ws + WS_FLOG * MiB))
#define FC ((float*)(ws + WS_FC * MiB))
#define SS ((float*)(ws + WS_SS * MiB))
#define MEMK ((bf16_t*)(ws + WS_MEMK * MiB))
#define MEMVT ((bf16_t*)(ws + WS_MEMVT * MiB))
#define Z ((bf16_t*)(ws + WS_Z * MiB))
#define GATES ((bf16_t*)(ws + WS_GATES * MiB))
#define ACC32 ((float*)(ws + WS_ACC32 * MiB))
#define MERGED ((bf16_t*)(ws + WS_MERGED * MiB))
#define X1B ((bf16_t*)(ws + WS_X1B * MiB))
#define Y ((bf16_t*)(ws + WS_Y * MiB))
#define HCAT ((bf16_t*)out)
#define YABC ((bf16_t*)out)
    const size_t ZS = (size_t)MTOK * 512;

#ifndef NO_P0
#ifdef DUP_P0
    for (int rep0 = 0; rep0 < 2; ++rep0)
#endif
    {
        if (bx == 0 && tid == 0) { ctl[0] = 0u; ctl[1] = 0u; ctl[64] = 0u; }
        if (bx == 0 && tid < 384) { const int t_ = tid; float* gt = (float*)(ctl + 2048); gt[t_] = t_ < 64 ? fox_q_g[t_] : (t_ < 128 ? fox_k_g[t_ - 64] : (t_ < 256 ? mem_q_g[t_ - 128] : mem_k_g[t_ - 256])); }
        LAS float* ffw = (LAS float*)(lds + 73728);
        for (int idx = tid; idx < 8192; idx += 512) { const int k = idx >> 3, jj = idx & 7; ffw[jj * 1024 + k] = w_in[(size_t)k * INC + 3584 + jj]; }
        __syncthreads();
        LAS float* scr = (LAS float*)(lds + wid * 8448);
        const int gw = bx * 8 + wid, NGW = G * 8;
        constexpr int I0 = 16 * 224, I1 = 16 * 32, I2 = 8 * 32, I3 = 16 * 32, I4 = 16 * 176, I5 = 44 * 32;
        constexpr int NIT = I0 + I1 + 3 * I2 + I3 + I4 + I5;
        for (int it = gw; it < NIT; it += NGW) {
            int r = it;
            if (r < I0) { const int kb = r / 224, nb = r % 224, n0 = nb * 32; transpose_item(w_in, INC, 1024, WCAT, n0, n0 < 3584 ? n0 : n0 + 8, kb * 64, nullptr, scr, lane); continue; } r -= I0;
            if (r < I1) { const int kb = r / 32, nb = r % 32; transpose_item(mem_kv_w, 1024, 1024, WCAT + (size_t)7168 * 1024, nb * 32, nb * 32, kb * 64, nullptr, scr, lane); continue; } r -= I1;
            if (r < 3 * I2) { const int j = r / I2, rr = r % I2, kb = rr / 32, nb = rr % 32; const float* W = j == 0 ? w_br_h : (j == 1 ? w_br_f : w_br_m);
                transpose_item(W, 1024, 512, WBR + (size_t)j * 1024 * 512, nb * 32, nb * 32, kb * 64, nullptr, scr, lane); continue; } r -= 3 * I2;
            if (r < I3) { const int kb = r / 32, nb = r % 32; transpose_item(w_out, 1024, 1024, WOUT, nb * 32, nb * 32, kb * 64, nullptr, scr, lane); continue; } r -= I3;
            if (r < I4) { const int kb = r / 176, nb = r % 176, n0 = nb * 32; const int pn = n0 >> 8, bj = (n0 >> 7) & 1, cc = n0 & 127;
                transpose_item(w_up, 2 * FFD, 1024, WUP, n0, bj * FFD + 128 * pn + cc, kb * 64, norm_ffn_g, scr, lane); continue; } r -= I4;
            { const int kb = r / 32, nb = r % 32; transpose_item(w_down, 1024, FFD, WDOWN, nb * 32, nb * 32, kb * 64, nullptr, scr, lane); }
        }
        norm_rows<true>(x, MTOK, gw, NGW, norm_mix_g, HCAT, ffw, fox_f_bias, FLOG, lane);
        norm_rows<false>(mem, MMEM, gw, NGW, norm_mem_g, HCAT + (size_t)MTOK * DM, ffw, nullptr, nullptr, lane);
    }
#endif
    grid.sync();

#ifndef NO_P1
    {
        LAS float* wt = (LAS float*)(lds + LDS_X); LAS float* FcL = (LAS float*)(lds + LDS_X + 1024);
        for (int bh = bx; bh < 256; bh += G) { const int b = bh >> 3, h = bh & 7;
            float v[4]; float run = 0.f;
#pragma unroll
            for (int e = 0; e < 4; ++e) { run += FLOG[((size_t)b * NT + 4 * tid + e) * 8 + h]; v[e] = run; }
            float inc = run;
#pragma unroll
            for (int o = 1; o < 64; o <<= 1) { const int l_ = lane_id(); const float t = __int_as_float(__builtin_amdgcn_ds_bpermute((l_ - o) << 2, __float_as_int(inc))); if (l_ >= o) inc += t; }
            if (lane == 63) wt[wid] = inc;
            __syncthreads();
            float pre = inc - run;
            for (int w = 0; w < wid; ++w) pre += wt[w];
            const f32x4 fc4 = {pre + v[0], pre + v[1], pre + v[2], pre + v[3]};
            *(f32x4*)(FC + (size_t)bh * NT + 4 * tid) = fc4; *(LAS f32x4*)(FcL + 4 * tid) = fc4;
            __syncthreads();
            { float gq = fabsf(fox_q_g[lane]), gk = fabsf(fox_k_g[lane]);
                gq = xmax64(gq); gk = xmax64(gk);
                const float L2 = 2.f * 8.f * 1.02f * gq * gk;
                const int l_ = lane;
                for (int i = 0; i < 8; ++i) { const int rb = 8 * wid + i; bool skip = false;
                    if (l_ < ((rb >> 1) + 1)) skip = (L2 + FcL[32 * rb] - FcL[64 * l_ + 63]) * 1.4426950408889634f < -127.f;
                    const int k0t = __builtin_popcountll(__ballot(skip));
                    if (l_ == 0) ((int*)ctl)[4096 + bh * 64 + rb] = k0t; } }
            __syncthreads();
        }
        SchedIn S{G, bx, (const char*)HCAT, (const char*)WCAT};
        EpiIn E{Z, GATES, MEMK, MEMVT, lb_logits, (const float*)(ctl + 2048), (LAS float*)(lds + LDS_X + 8192)};
#ifdef DUP_P1
        pg8::gemm_phase<EpiIn, SchedIn>(lds, 1024, S, E, wv);
#endif
        pg8::gemm_phase<EpiIn, SchedIn>(lds, 1024, S, E, wv);
    }
#endif
    grid_bar(ctl + 64, 1u * (unsigned)G, wv);

#ifndef NO_P2
    {
        LAS int* slot = (LAS int*)(lds + LDS_BYTES - 64);
#ifdef DUP_P2
        for (int rep = 0; rep < 2; ++rep)
#else
        const int rep = 0;
#endif
        __syncthreads();
        if (tid == 0) *slot = (int)atomicAdd(ctl + rep, 1u);
        for (;;) {
            __syncthreads();
            const int it = *slot;
            if (it >= 128 + 256 + 2048) break;
            unsigned nxt = 0u;
            if (tid == 0) nxt = atomicAdd(ctl + rep, 1u);
            __syncthreads();
            if (it < 128) { hgrn_unit(lds, Z + 0 * ZS, Z + 1 * ZS, Z + 2 * ZS, Z + 3 * ZS, hgrn_norm_g, YABC, it >> 2, it & 3, wv); }
            else if (it < 128 + 256) { const int r = it - 128, half = r & 1, bh = r >> 1, b = bh >> 2, h = bh & 3;
                mem_unit(lds, Z + 7 * ZS + ((size_t)b * NT + half * 1024) * 512 + h * 128, MEMK + (size_t)b * NMEM * 512 + h * 128, MEMVT + (size_t)bh * 128 * 256, mem_q_g, mem_k_g,
                         YABC + 2 * ZS + ((size_t)b * NT + half * 1024) * 512 + h * 128, wv); }
            else { const int r = it - 128 - 256, qb = 7 - (r >> 8), bh = r & 255, b = bh >> 3, h = bh & 7;
                fox_unit(lds, Z + 4 * ZS + (size_t)b * NT * 512 + h * 64, Z + 5 * ZS + (size_t)b * NT * 512 + h * 64, Z + 6 * ZS + (size_t)bh * 64 * 2048, fox_q_g, fox_k_g, FC + (size_t)bh * NT, qb * 256, 4 * (qb + 1), (const int*)ctl + 4096 + bh * 64,
                         YABC + ZS + (size_t)b * NT * 512 + h * 64, wv); }
            if (tid == 0) *slot = (int)nxt;
        }
    }
#endif
    grid_bar(ctl + 64, 2u * (unsigned)G, wv);

#ifndef NO_P3
    for (int p = bx; p < 256; p += G) {
        {
            SchedMerge S{p, (const char*)YABC, (const char*)WBR};
            EpiMerge E{GATES, (bf16_t*)ACC32, MERGED};
            pg8::gemm_phase<EpiMerge, SchedMerge>(lds, 512, S, E, wv);
        }
        __syncthreads();
        {
            SchedPanel S{p, (const char*)MERGED, (const char*)WOUT, 2048};
            EpiOut E{x, X1B, SS, (LAS float*)(lds + LDS_X + 8192), wv};
            pg8::gemm_phase<EpiOut, SchedPanel>(lds, 1024, S, E, wv);
        }
    }
#endif
    grid_bar(ctl + 64, 3u * (unsigned)G, wv);

#ifndef NO_P5
    {
        SchedPlain S{G, bx, 259, 22, 254, -2, (const char*)X1B, (const char*)WUP, 2048};
        EpiUp E{SS, conv_w, conv_b, Y, (LAS float*)(lds + LDS_X + 256)};
#ifdef DUP_P5
        pg8::gemm_phase<EpiUp, SchedPlain>(lds, 1024, S, E, wv);
#endif
        pg8::gemm_phase<EpiUp, SchedPlain>(lds, 1024, S, E, wv);
    }
#endif
    grid_bar(ctl + 64, 4u * (unsigned)G, wv);

#ifndef NO_P6
    {
        SchedPlain S{G, bx, 256, 4, 256, 0, (const char*)Y, (const char*)WDOWN, 2 * FFD};
        EpiDown E{X1B, out};
        pg8::gemm_phase<EpiDown, SchedPlain>(lds, FFD, S, E, wv);
    }
#endif
}

#undef tid
#undef lane
#undef wid
#undef ws
#undef x
#undef mem
#undef norm_mix_g
#undef norm_mem_g
#undef w_in
#undef lb_logits
#undef hgrn_norm_g
#undef fox_f_bias
#undef fox_q_g
#undef fox_k_g
#undef mem_kv_w
#undef mem_q_g
#undef mem_k_g
#undef w_br_h
#undef w_br_f
#undef w_br_m
#undef w_out
#undef norm_ffn_g
#undef w_up
#undef conv_w
#undef conv_b
#undef w_down
#undef out
#undef ctl
#undef WCAT
#undef WBR
#undef WOUT
#undef WUP
#undef WDOWN
#undef FLOG
#undef FC
#undef SS
#undef MEMK
#undef MEMVT
#undef Z
#undef GATES
#undef ACC32
#undef MERGED
#undef X1B
#undef Y
#undef HCAT
#undef YABC
extern "C" void kernel_launch(void* const* d_in, const int* in_sizes, int n_in, void* d_out, int out_size, void* d_ws, size_t ws_size, hipStream_t stream) {
    static int grid = 0;
    if (grid == 0) {
        int dev = 0, cus = 0, per_cu = 0;
        hipGetDevice(&dev);
        hipDeviceGetAttribute(&cus, hipDeviceAttributeMultiprocessorCount, dev);
        hipFuncSetAttribute((const void*)fwd_mega, hipFuncAttributeMaxDynamicSharedMemorySize, LDS_BYTES);
        hipOccupancyMaxActiveBlocksPerMultiprocessor(&per_cu, (const void*)fwd_mega, 512, LDS_BYTES);
        if (per_cu < 1) per_cu = 1;
        grid = cus * per_cu;
        (void)hipGetLastError();
    }
    Params p{};
    for (int i = 0; i < 22; ++i) p.in[i] = (const float*)d_in[i];
    p.out = (float*)d_out; p.ws = (unsigned char*)d_ws;
    void* args[] = {&p};
    hipError_t e = hipLaunchCooperativeKernel((const void*)fwd_mega, dim3(grid), dim3(512), args, LDS_BYTES, stream);
    if (e != hipSuccess) fprintf(stderr, "cooperative launch failed: %s (grid %d)\n", hipGetErrorString(e), grid);
}
```

```cpp
#include <hip/hip_runtime.h>
#include <hip/hip_cooperative_groups.h>
#include <cstdio>
#include <cstdint>
namespace cg = cooperative_groups;

#define LAS __attribute__((address_space(3)))
typedef unsigned short bf16_t;
typedef short bf16x8 __attribute__((ext_vector_type(8)));
typedef float f32x4 __attribute__((ext_vector_type(4)));
typedef float f32x2 __attribute__((ext_vector_type(2)));
typedef unsigned u32x4 __attribute__((ext_vector_type(4)));
typedef unsigned u32x2 __attribute__((ext_vector_type(2)));

constexpr int NB = 32, NT = 2048, DM = 1024, MTOK = NB * NT, NMEM = 256, MMEM = NB * NMEM;
constexpr int INC = 7176, FFD = 2816;
constexpr float EPS = 1e-6f;
constexpr size_t MiB = 1u << 20;
constexpr size_t WS_CTL = 0, WS_WCAT = 1, WS_WBR = 17, WS_WOUT = 20, WS_WUP = 22, WS_WDOWN = 33, WS_FLOG = 40, WS_FC = 42, WS_SS = 44,
                 WS_MEMK = 48, WS_MEMVT = 56, WS_Z = 64, WS_GATES = 576, WS_ACC32 = 64, WS_MERGED = 320, WS_X1B = 448, WS_Y = 600;
constexpr int LDS_BYTES = 147456;
constexpr int LDS_X = 131072;

__device__ __forceinline__ unsigned f2bf(float f) { unsigned u = __builtin_bit_cast(unsigned, f); return (u + 0x7fffu + ((u >> 16) & 1u)) >> 16; }
typedef __bf16 bf16x2_t __attribute__((ext_vector_type(2)));
__device__ __forceinline__ unsigned pk2(float lo, float hi) { const f32x2 v = {lo, hi}; const bf16x2_t b = __builtin_convertvector(v, bf16x2_t); return __builtin_bit_cast(unsigned, b); }
__device__ __forceinline__ unsigned f2bf_hw(float f) { return pk2(f, 0.f) & 0xffffu; }
__device__ __forceinline__ float bflo(unsigned u) { return __builtin_bit_cast(float, u << 16); }
__device__ __forceinline__ float bfhi(unsigned u) { return __builtin_bit_cast(float, u & 0xffff0000u); }
__device__ __forceinline__ float bf1(bf16_t u) { return __builtin_bit_cast(float, (unsigned)u << 16); }
__device__ __forceinline__ int lane_id() { int l = (int)__builtin_amdgcn_mbcnt_hi(~0u, __builtin_amdgcn_mbcnt_lo(~0u, 0u)); asm volatile("" : "+v"(l)); return l; }
__device__ __forceinline__ int tid_from(int wv) { return wv * 64 + lane_id(); }
template <int O> __device__ __forceinline__ float sxor(float v) {
    if constexpr (O == 32) { auto rr = __builtin_amdgcn_permlane32_swap(__float_as_uint(v), __float_as_uint(v), false, false); const unsigned a = rr[0], b = rr[1]; return (lane_id() & 32) ? __uint_as_float(a) : __uint_as_float(b); }
    else return __int_as_float(__builtin_amdgcn_ds_swizzle(__float_as_int(v), (O << 10) | 0x1f));
}
__device__ __forceinline__ float xsum64(float v) { v += sxor<1>(v); v += sxor<2>(v); v += sxor<4>(v); v += sxor<8>(v); v += sxor<16>(v); v += sxor<32>(v); return v; }
__device__ __forceinline__ float xmax64(float v) { v = fmaxf(v, sxor<1>(v)); v = fmaxf(v, sxor<2>(v)); v = fmaxf(v, sxor<4>(v)); v = fmaxf(v, sxor<8>(v)); v = fmaxf(v, sxor<16>(v)); v = fmaxf(v, sxor<32>(v)); return v; }
__device__ __forceinline__ float wave_sum(float v) { return xsum64(v); }
__device__ __forceinline__ float sigmoidf_(float x) { return __builtin_amdgcn_rcpf(1.f + __builtin_amdgcn_exp2f(x * -1.4426950408889634f)); }

namespace pg8 {
constexpr int BM = 256, BK = 64, HALF = 128, HTB = HALF * BK * 2, NXCD = 8, WGM = 8;
__host__ __device__ __forceinline__ int lds_byte(int r, int c) { const int st = (r >> 4) * 2 + (c >> 5), rr = r & 15, cc = c & 31, ob = rr * 64 + cc * 2; return st * 1024 + (ob ^ (((ob >> 9) & 1) << 5)); }
__host__ __device__ __forceinline__ void stage_rc(int b, int& R, int& C) { const int st = b / 1024, sb = b % 1024, swz = sb ^ (((sb >> 9) & 1) << 5); R = (st >> 1) * 16 + swz / 64; C = (st & 1) * 32 + (swz % 64) / 2; }
__host__ __device__ __forceinline__ int perm32(int rho) { const int n = rho >> 4, i = rho & 15; return 8 * (i >> 2) + 4 * n + (i & 3); }
struct Unit { int pm, pn; };
struct Gemm { const bf16_t* A; const bf16_t* Bt; int K; };
__device__ __forceinline__ void swz_unit(int L, int nM, int nN, Unit& u) {
    int wgid = L; const int nwg = nM * nN; { const int q = nwg / NXCD, r = nwg % NXCD, xcd = wgid % NXCD, off = wgid / NXCD; wgid = (xcd < r ? xcd * (q + 1) : r * (q + 1) + (xcd - r) * q) + off; }
    const int nig = WGM * nN, gid = wgid / nig, fm = gid * WGM, gsz = (nM - fm) < WGM ? (nM - fm) : WGM;
    u.pm = fm + ((wgid % nig) % gsz); u.pn = (wgid % nig) / gsz;
}
__device__ __forceinline__ unsigned cvt_pk_bf16(float lo, float hi) { unsigned r; asm volatile("v_cvt_pk_bf16_f32 %0, %1, %2" : "=v"(r) : "v"(lo), "v"(hi)); return r; }
__device__ __forceinline__ f32x2 gelu_pk(f32x2 x) {
    const f32x2 u0 = x * 0.70710678f; f32x2 u; u.x = __builtin_amdgcn_fmed3f(u0.x, -3.2f, 3.2f); u.y = __builtin_amdgcn_fmed3f(u0.y, -3.2f, 3.2f);
    const f32x2 t = (u * u) * 0.1953125f - 1.0f;
    f32x2 p = t * 2.982273671e-03f + (-7.046153472e-03f);
    p = p * t + 7.957076705e-03f; p = p * t + (-1.521942819e-02f); p = p * t + 3.318292224e-02f; p = p * t + (-5.471928813e-02f); p = p * t + 8.062700147e-02f;
    p = p * t + (-1.136467381e-01f); p = p * t + 1.543549678e-01f; p = p * t + (-2.173077339e-01f); p = p * t + 4.413341836e-01f;
    const f32x2 e = u * p, hx = x * 0.5f;
    return hx + hx * e;
}

template <class Epi, class Sched>
__device__ __forceinline__ void gemm_phase(LAS unsigned char* lds, const int K, const Sched& S, const Epi& E, const int wv) {
    const int tid = tid_from(wv);
    const int wid = wv, lane = tid & 63, wr = wid >> 2, wc = wid & 3, fr = lane & 15, fq = lane >> 4;
    const int nt = K / BK;
    unsigned voffA[2], voffB[2];
#pragma unroll
    for (int i = 0; i < 2; ++i) { int R, C; stage_rc(tid * 16 + i * 8192, R, C); const int Rb = (R & ~31) + perm32(R & 31);
        voffA[i] = (unsigned)(R * K + C) * 2u; voffB[i] = (unsigned)(Rb * K + C) * 2u; }
    const size_t kstep = (size_t)(BK * 2);
    const size_t hstep = (size_t)HALF * K * 2;
    const unsigned ldsw = (unsigned)wid * 1024u;
    const int aoff = lds_byte(wr * 64 + fr, fq * 8), boff = lds_byte(wc * 32 + fr, fq * 8);
#define PG8_SA(b, h) (((b) * 2 + (h)) * HTB)
#define PG8_SB(b, h) ((4 + (b) * 2 + (h)) * HTB)
#define PG8_STAGE(bufoff, gbase, voff) do { _Pragma("unroll") for (int _i = 0; _i < 2; ++_i) \
        __builtin_amdgcn_global_load_lds((const unsigned*)((const char*)(gbase) + (voff)[_i]), (LAS unsigned*)(lds + (bufoff) + ldsw + _i * 8192), 16, 0, 0); } while (0)
#define PG8_LDA(dst, b, h) do { _Pragma("unroll") for (int m = 0; m < 4; ++m) _Pragma("unroll") for (int k = 0; k < 2; ++k) dst[m][k] = *(const LAS bf16x8*)(lds + PG8_SA(b, h) + aoff + m * 2048 + k * 1024); } while (0)
#define PG8_LDB(dst, b, h) do { _Pragma("unroll") for (int n = 0; n < 2; ++n) _Pragma("unroll") for (int k = 0; k < 2; ++k) dst[n][k] = *(const LAS bf16x8*)(lds + PG8_SB(b, h) + boff + n * 2048 + k * 1024); } while (0)
#define PG8_MMA(ai, bj, At, Bt) do { __builtin_amdgcn_s_setprio(1); _Pragma("unroll") for (int m = 0; m < 4; ++m) _Pragma("unroll") for (int n = 0; n < 2; ++n) _Pragma("unroll") for (int k = 0; k < 2; ++k) \
        acc[ai][bj][m][n] = __builtin_amdgcn_mfma_f32_16x16x32_bf16(Bt[n][k], At[m][k], acc[ai][bj][m][n], 0, 0, 0); __builtin_amdgcn_s_setprio(0); } while (0)
#define PG8_WAIT_V(n) asm volatile("s_waitcnt vmcnt(" #n ")" ::: "memory")
#define PG8_WAIT_L(n) asm volatile("s_waitcnt lgkmcnt(" #n ")" ::: "memory")
#define PG8_BAR __builtin_amdgcn_s_barrier()
#define PG8_SCHED __builtin_amdgcn_sched_barrier(0)
    Unit cur, nxt; int ui = 0;
    if (!S.next(0, cur)) return;
    cur.pm = __builtin_amdgcn_readfirstlane(cur.pm); cur.pn = __builtin_amdgcn_readfirstlane(cur.pn);
    f32x4 acc[2][2][4][2];
#pragma unroll
    for (int a = 0; a < 2; ++a)
#pragma unroll
        for (int b = 0; b < 2; ++b)
#pragma unroll
            for (int m = 0; m < 4; ++m)
#pragma unroll
                for (int n = 0; n < 2; ++n) acc[a][b][m][n] = (f32x4){0.f, 0.f, 0.f, 0.f};
    bf16x8 At[4][2], B0[2][2], B1[2][2];
    const char* cA = S.aptr(cur); const char* cB = S.bptr(cur);
    PG8_STAGE(PG8_SB(0, 0), cB, voffB); PG8_STAGE(PG8_SB(0, 1), cB + hstep, voffB); PG8_STAGE(PG8_SA(0, 0), cA, voffA); PG8_STAGE(PG8_SA(0, 1), cA + hstep, voffA);
    if (wr == 1) PG8_BAR;
    PG8_WAIT_V(2); PG8_BAR;
    PG8_STAGE(PG8_SB(1, 0), cB + kstep, voffB); PG8_STAGE(PG8_SA(1, 0), cA + kstep, voffA); PG8_STAGE(PG8_SB(1, 1), cB + hstep + kstep, voffB);
    PG8_WAIT_V(6); PG8_BAR;
    for (;;) {
        const bool has_next = S.next(ui + 1, nxt);
        nxt.pm = __builtin_amdgcn_readfirstlane(nxt.pm); nxt.pn = __builtin_amdgcn_readfirstlane(nxt.pn);
        const char* nA = has_next ? S.aptr(nxt) : cA; const char* nB = has_next ? S.bptr(nxt) : cB;
        for (int t = 0; t < nt; t += 2) {
            const bool last = (t == nt - 2);
            const char* a1 = cA + (size_t)(t + 1) * kstep;
            const char* a2 = last ? nA : cA + (size_t)(t + 2) * kstep; const char* b2 = last ? nB : cB + (size_t)(t + 2) * kstep;
            const char* a3 = a2 + kstep; const char* b3 = b2 + kstep;
            PG8_LDB(B0, 0, 0); PG8_LDB(B1, 0, 1); PG8_SCHED; PG8_LDA(At, 0, 0); PG8_STAGE(PG8_SA(1, 1), a1 + hstep, voffA);
            PG8_WAIT_V(8); PG8_WAIT_L(0); PG8_BAR; PG8_MMA(0, 0, At, B0); PG8_MMA(0, 1, At, B1); PG8_BAR; PG8_SCHED;
            PG8_LDA(At, 0, 1); PG8_STAGE(PG8_SB(0, 0), b2, voffB); PG8_STAGE(PG8_SB(0, 1), b2 + hstep, voffB); PG8_STAGE(PG8_SA(0, 0), a2, voffA);
            PG8_WAIT_V(8); PG8_WAIT_L(0); PG8_BAR; PG8_MMA(1, 0, At, B0); PG8_MMA(1, 1, At, B1); PG8_BAR; PG8_SCHED;
            PG8_LDB(B0, 1, 0); PG8_LDB(B1, 1, 1); PG8_SCHED; PG8_LDA(At, 1, 0); PG8_STAGE(PG8_SA(0, 1), a2 + hstep, voffA);
            PG8_WAIT_V(8); PG8_WAIT_L(0); PG8_BAR; PG8_MMA(0, 0, At, B0); PG8_MMA(0, 1, At, B1); PG8_BAR; PG8_SCHED;
            PG8_LDA(At, 1, 1); PG8_STAGE(PG8_SB(1, 0), b3, voffB); PG8_STAGE(PG8_SB(1, 1), b3 + hstep, voffB); PG8_STAGE(PG8_SA(1, 0), a3, voffA);
            PG8_WAIT_V(8); PG8_WAIT_L(0); PG8_BAR; PG8_MMA(1, 0, At, B0); PG8_MMA(1, 1, At, B1); PG8_BAR; PG8_SCHED;
        }
        if (wr == 0) PG8_BAR;
        E(acc, cur, wr, wc, fr, fq);
        if (!has_next) break;
#pragma unroll
        for (int a = 0; a < 2; ++a)
#pragma unroll
            for (int b = 0; b < 2; ++b)
#pragma unroll
                for (int m = 0; m < 4; ++m)
#pragma unroll
                    for (int n = 0; n < 2; ++n) acc[a][b][m][n] = (f32x4){0.f, 0.f, 0.f, 0.f};
        cur = nxt; cA = nA; cB = nB; ++ui;
        if (wr == 1) PG8_BAR;
    }
    PG8_WAIT_V(0);
    PG8_BAR;
#undef PG8_SA
#undef PG8_SB
#undef PG8_STAGE
#undef PG8_LDA
#undef PG8_LDB
#undef PG8_MMA
#undef PG8_WAIT_V
#undef PG8_WAIT_L
#undef PG8_BAR
#undef PG8_SCHED
}
}
using pg8::Unit;
typedef f32x4 (&AccRef)[2][2][4][2];

struct SchedIn {
    int G, c; const char* H; const char* W;
    __device__ __forceinline__ bool next(int i, Unit& u) const {
        int L = i * G + c;
        if (L < 6656) { pg8::swz_unit(L, 256, 26, u); u.pn = u.pn < 12 ? u.pn : u.pn + 2; return true; }
        L -= 6656;
        if (L < 512) { u.pm = 1024 + (L & 1); u.pn = L >> 1; return true; }
        L -= 512;
        if (L < 64) { u.pm = 2048 + (L >> 1); u.pn = 28 + (L & 1); return true; }
        L -= 64;
        if (L < 64) { u.pm = 3072 + (L & 1); u.pn = L >> 1; return true; }
        return false;
    }
    __device__ __forceinline__ const char* aptr(const Unit& u) const { const int ty = u.pm >> 10, idx = u.pm & 1023;
        const long row = ty == 0 ? (long)idx * 256 : (ty == 1 ? (long)(12 + idx) * 256 : (ty == 2 ? (long)MTOK + idx * 256 : (long)(30 + idx) * 256));
        return ((ty & 1) ? W : H) + row * 2048; }
    __device__ __forceinline__ const char* bptr(const Unit& u) const { const int ty = u.pm >> 10;
        const long row = ty == 3 ? (long)MTOK + u.pn * 256 : (long)u.pn * 256;
        return ((ty & 1) ? H : W) + row * 2048; }
};
struct SchedMerge {
    int p; const char* A; const char* B;
    __device__ __forceinline__ bool next(int i, Unit& u) const {
        if (i >= 12) return false; const int pn = i / 3, j = i - 3 * pn; u.pm = j * 256 + p; u.pn = j * 4 + pn; return true;
    }
    __device__ __forceinline__ const char* aptr(const Unit& u) const { return A + (long)u.pm * 256 * 1024; }
    __device__ __forceinline__ const char* bptr(const Unit& u) const { return B + (long)u.pn * 256 * 1024; }
};
struct SchedPanel {
    int p; const char* A; const char* B; long rowb;
    __device__ __forceinline__ bool next(int i, Unit& u) const { if (i >= 4) return false; u.pm = p; u.pn = i; return true; }
    __device__ __forceinline__ const char* aptr(const Unit& u) const { return A + (long)u.pm * 256 * rowb; }
    __device__ __forceinline__ const char* bptr(const Unit& u) const { return B + (long)u.pn * 256 * rowb; }
};
struct SchedPlain {
    int G, c, nM, nN, rstride, roff; const char* A; const char* B; long rowb;
    __device__ __forceinline__ bool next(int i, Unit& u) const {
        const int L = i * G + c; if (L >= nM * nN) return false;
        pg8::swz_unit(L, nM, nN, u); return true;
    }
    __device__ __forceinline__ const char* aptr(const Unit& u) const { return A + ((long)u.pm * rstride + roff) * rowb; }
    __device__ __forceinline__ const char* bptr(const Unit& u) const { return B + (long)u.pn * 256 * rowb; }
};

struct EpiIn {
    bf16_t* z; bf16_t* gates; bf16_t* memk; bf16_t* memvt; const float* lbl; const float* gtab; LAS float* hs;
    __device__ __forceinline__ void operator()(AccRef acc, const Unit& u, int wr, int wc, int fr, int fq) const {
        const int ty = u.pm >> 10, idx = u.pm & 1023, pn = u.pn;
        bf16_t* base; size_t ldc; int mode = 0; int c0; int rbase;
        if (ty == 1) {
            const int tk = pn * 256 + wc * 32 + 8 * fq; const int b = tk >> 11;
            base = z + 6 * ((size_t)MTOK * 512) + (size_t)b * 512 * 2048; ldc = 2048; c0 = tk & 2047; rbase = idx * 256 + wr * 64 + fr;
        } else if (ty == 3) {
            const int mi = pn * 256 + wc * 32 + 8 * fq; const int b = mi >> 8;
            base = memvt + (size_t)b * 512 * 256; ldc = 256; c0 = mi & 255; rbase = idx * 256 + wr * 64 + fr;
        } else if (ty == 2) {
            base = memk; ldc = 512; c0 = (pn - 28) * 256 + wc * 32 + 8 * fq; rbase = idx * 256 + wr * 64 + fr; mode = 5;
        } else if (pn >= 16) {
            base = gates; ldc = 3072; c0 = (pn - 16) * 256 + wc * 32 + 8 * fq; rbase = idx * 256 + wr * 64 + fr; mode = 3;
        } else { const int reg = pn >> 1;
            base = z + (size_t)reg * ((size_t)MTOK * 512); ldc = 512; c0 = (pn & 1) * 256 + wc * 32 + 8 * fq; rbase = idx * 256 + wr * 64 + fr;
            mode = (reg == 0 || reg == 3) ? 1 : (reg == 1 ? 2 : ((reg == 4 || reg == 5) ? 4 : (reg == 7 ? 5 : 0)));
        }
        if (mode >= 4) {
            const int rloc = wr * 64 + fr; const bool wide = (mode == 5); const bool isq = wide ? (ty == 0) : (pn < 10);
#pragma unroll
            for (int ai = 0; ai < 2; ++ai)
#pragma unroll
                for (int m = 0; m < 4; ++m)
#pragma unroll
                    for (int bj = 0; bj < 2; ++bj) { const f32x4 a0 = acc[ai][bj][m][0], a1 = acc[ai][bj][m][1];
                        float sq = (a0[0] * a0[0] + a0[1] * a0[1]) + (a0[2] * a0[2] + a0[3] * a0[3]) + (a1[0] * a1[0] + a1[1] * a1[1]) + (a1[2] * a1[2] + a1[3] * a1[3]);
                        sq += sxor<16>(sq); sq += sxor<32>(sq);
                        if (fq == 0) hs[((rloc + ai * 128 + m * 16) * 2 + bj) * 4 + wc] = sq; }
            asm volatile("s_waitcnt lgkmcnt(0)" ::: "memory");
            __builtin_amdgcn_s_barrier();
            const float* gp = gtab + (wide ? (isq ? 128 : 256) + wc * 32 : (isq ? 0 : 64) + (wc & 1) * 32) + 8 * fq;
            const float gsc = isq ? (wide ? 0.08838834764831845f : 0.125f) * 1.4426950408889634f : 1.f;
            float gg[8];
#pragma unroll
            for (int i = 0; i < 8; ++i) gg[i] = gp[i] * gsc;
#pragma unroll
            for (int ai = 0; ai < 2; ++ai)
#pragma unroll
                for (int m = 0; m < 4; ++m)
#pragma unroll
                    for (int bj = 0; bj < 2; ++bj) { const LAS float* hp = hs + ((rloc + ai * 128 + m * 16) * 2 + bj) * 4; const f32x4 h4 = *(const LAS f32x4*)hp;
                        const float rs = wide ? __builtin_amdgcn_rsqf(((h4[0] + h4[1]) + (h4[2] + h4[3])) * (1.f / 128.f) + EPS) : __builtin_amdgcn_rsqf(((wc & 2) ? (h4[2] + h4[3]) : (h4[0] + h4[1])) * (1.f / 64.f) + EPS);
                        const f32x4 a0 = acc[ai][bj][m][0], a1 = acc[ai][bj][m][1];
                        u32x4 w; w.x = pk2(a0[0] * rs * gg[0], a0[1] * rs * gg[1]); w.y = pk2(a0[2] * rs * gg[2], a0[3] * rs * gg[3]); w.z = pk2(a1[0] * rs * gg[4], a1[1] * rs * gg[5]); w.w = pk2(a1[2] * rs * gg[6], a1[3] * rs * gg[7]);
                        *(u32x4*)(base + (size_t)(rbase + ai * 128 + m * 16) * ldc + c0 + bj * 128) = w; }
            return;
        }
#pragma unroll
        for (int bj = 0; bj < 2; ++bj) {
            float lb[8];
            if (mode == 2) {
#pragma unroll
                for (int i = 0; i < 8; ++i) { const float l0 = lbl[c0 + bj * 128 + i], l1 = lbl[512 + c0 + bj * 128 + i]; lb[i] = __builtin_amdgcn_rcpf(1.f + __expf(l1 - l0)); }
            }
#pragma unroll
            for (int ai = 0; ai < 2; ++ai)
#pragma unroll
                for (int m = 0; m < 4; ++m) { float v[8];
#pragma unroll
                    for (int i = 0; i < 8; ++i) v[i] = acc[ai][bj][m][i >> 2][i & 3];
                    if (mode == 1) {
#pragma unroll
                        for (int i = 0; i < 8; ++i) v[i] = v[i] * sigmoidf_(v[i]);
                    } else if (mode == 2) {
#pragma unroll
                        for (int i = 0; i < 8; ++i) v[i] = __logf(lb[i] + (1.f - lb[i]) * sigmoidf_(v[i]));
                    } else if (mode == 3) {
#pragma unroll
                        for (int i = 0; i < 8; ++i) v[i] = sigmoidf_(v[i]);
                    }
                    u32x4 w; w.x = pk2(v[0], v[1]); w.y = pk2(v[2], v[3]); w.z = pk2(v[4], v[5]); w.w = pk2(v[6], v[7]);
                    *(u32x4*)(base + (size_t)(rbase + ai * 128 + m * 16) * ldc + c0 + bj * 128) = w; }
        }
    }
};

struct EpiMerge {
    const bf16_t* gates; bf16_t* part; bf16_t* merged;
    __device__ __forceinline__ void operator()(AccRef acc, const Unit& u, int wr, int wc, int fr, int fq) const {
        const int j = u.pm >> 8, pm = u.pm & 255, pn = u.pn & 3;
        const int rbase = pm * 256 + wr * 64 + fr, c0 = pn * 256 + wc * 32 + 8 * fq;
#pragma unroll
        for (int ai = 0; ai < 2; ++ai)
#pragma unroll
            for (int m = 0; m < 4; ++m) { const size_t r = (size_t)(rbase + ai * 128 + m * 16);
#pragma unroll
                for (int bj = 0; bj < 2; ++bj) { const int c = c0 + bj * 128;
                    const u32x4 gw = *(const u32x4*)(gates + r * 3072 + j * 1024 + c);
                    f32x4 v0 = acc[ai][bj][m][0], v1 = acc[ai][bj][m][1];
                    v0[0] *= bflo(gw.x); v0[1] *= bfhi(gw.x); v0[2] *= bflo(gw.y); v0[3] *= bfhi(gw.y);
                    v1[0] *= bflo(gw.z); v1[1] *= bfhi(gw.z); v1[2] *= bflo(gw.w); v1[3] *= bfhi(gw.w);
                    if (j == 2) { const u32x4 p0 = *(const u32x4*)(part + r * 1024 + c), p1 = *(const u32x4*)(part + (size_t)MTOK * 1024 + r * 1024 + c);
                        v0[0] += bflo(p0.x) + bflo(p1.x); v0[1] += bfhi(p0.x) + bfhi(p1.x); v0[2] += bflo(p0.y) + bflo(p1.y); v0[3] += bfhi(p0.y) + bfhi(p1.y);
                        v1[0] += bflo(p0.z) + bflo(p1.z); v1[1] += bfhi(p0.z) + bfhi(p1.z); v1[2] += bflo(p0.w) + bflo(p1.w); v1[3] += bfhi(p0.w) + bfhi(p1.w); }
                    u32x4 w; w.x = pk2(v0[0], v0[1]); w.y = pk2(v0[2], v0[3]); w.z = pk2(v1[0], v1[1]); w.w = pk2(v1[2], v1[3]);
                    bf16_t* dst = (j == 2) ? merged : part + (size_t)j * MTOK * 1024;
                    *(u32x4*)(dst + r * 1024 + c) = w; } }
    }
};

struct EpiOut {
    const float* x; bf16_t* x1b; float* rstd; LAS float* rowss; int wv;
    __device__ __forceinline__ void operator()(AccRef acc, const Unit& u, int wr, int wc, int fr, int fq) const {
        const int rloc = wr * 64 + fr, rbase = u.pm * 256 + rloc, c0 = u.pn * 256 + wc * 32 + 8 * fq;
#pragma unroll
        for (int ai = 0; ai < 2; ++ai)
#pragma unroll
            for (int m = 0; m < 4; ++m) { const size_t r = (size_t)(rbase + ai * 128 + m * 16); float sq = 0.f;
#pragma unroll
                for (int bj = 0; bj < 2; ++bj) { const int c = c0 + bj * 128;
                    f32x4 v0 = acc[ai][bj][m][0] + *(const f32x4*)(x + r * 1024 + c), v1 = acc[ai][bj][m][1] + *(const f32x4*)(x + r * 1024 + c + 4);
                    sq += v0[0] * v0[0] + v0[1] * v0[1] + v0[2] * v0[2] + v0[3] * v0[3] + v1[0] * v1[0] + v1[1] * v1[1] + v1[2] * v1[2] + v1[3] * v1[3];
                    u32x4 w; w.x = pk2(v0[0], v0[1]); w.y = pk2(v0[2], v0[3]); w.z = pk2(v1[0], v1[1]); w.w = pk2(v1[2], v1[3]); *(u32x4*)(x1b + r * 1024 + c) = w; }
                sq += sxor<16>(sq); sq += sxor<32>(sq);
                if (fq == 0) { LAS float* sl = rowss + (rloc + ai * 128 + m * 16) * 4 + wc; *sl = (u.pn == 0) ? sq : (*sl + sq); } }
        if (u.pn == 3) {
            asm volatile("s_waitcnt lgkmcnt(0)" ::: "memory");
            __builtin_amdgcn_s_barrier();
            const int t = tid_from(wv);
            if (t < 256) { const f32x4 q = *(const LAS f32x4*)(rowss + t * 4); rstd[u.pm * 256 + t] = __builtin_amdgcn_rsqf(((q[0] + q[1]) + (q[2] + q[3])) * (1.f / 1024.f) + EPS); }
            asm volatile("s_waitcnt lgkmcnt(0)" ::: "memory");
            __builtin_amdgcn_s_barrier();
        }
    }
};

template <int CTRL> __device__ __forceinline__ float dppf(float v) {
    return __builtin_bit_cast(float, __builtin_amdgcn_update_dpp(0, __builtin_bit_cast(int, v), CTRL, 0xf, 0xf, true));
}
struct EpiUp {
    const float* ss; const float* cw; const float* cb; bf16_t* y; LAS float* hal;
    __device__ __forceinline__ void operator()(AccRef acc, const Unit& u, int wr, int wc, int fr, int fq) const {
        const int R0 = 254 * u.pm - 2 + wr * 64 + fr;
        const int chl = wc * 32 + 8 * fq;
        const int gch = u.pn * 128 + chl;
#pragma unroll
        for (int ai = 0; ai < 2; ++ai)
#pragma unroll
            for (int m = 0; m < 4; ++m) { const int R = R0 + ai * 128 + m * 16; float rs = 0.f;
                if (R >= 0 && R < MTOK) rs = ss[R];
#pragma unroll
                for (int bj = 0; bj < 2; ++bj)
#pragma unroll
                    for (int n = 0; n < 2; ++n) acc[ai][bj][m][n] = acc[ai][bj][m][n] * rs; }
        if (fr >= 14) {
#pragma unroll
            for (int ai = 0; ai < 2; ++ai) { LAS float* hp = hal + ((2 * ai + wr) * 2 + (fr - 14)) * 128 + chl;
                *(LAS f32x4*)hp = acc[ai][0][3][0]; *(LAS f32x4*)(hp + 4) = acc[ai][0][3][1]; }
        }
        asm volatile("s_waitcnt lgkmcnt(0)" ::: "memory");
        __builtin_amdgcn_s_barrier();
        f32x4 w0[2], w1[2], w2[2], bb[2];
#pragma unroll
        for (int n = 0; n < 2; ++n) { w0[n] = *(const f32x4*)(cw + gch + 4 * n); w1[n] = *(const f32x4*)(cw + FFD + gch + 4 * n); w2[n] = *(const f32x4*)(cw + 2 * FFD + gch + 4 * n); bb[n] = *(const f32x4*)(cb + gch + 4 * n); }
#pragma unroll
        for (int ai = 0; ai < 2; ++ai) { const int blk = 2 * ai + wr;
            f32x4 H[2]; H[0] = (f32x4){0.f, 0.f, 0.f, 0.f}; H[1] = H[0];
            if (fr >= 14 && blk >= 1) { const LAS float* hp = hal + ((blk - 1) * 2 + (fr - 14)) * 128 + chl; H[0] = *(const LAS f32x4*)hp; H[1] = *(const LAS f32x4*)(hp + 4); }
#pragma unroll
            for (int m = 3; m >= 0; --m) { const int tr = ai * 128 + wr * 64 + m * 16 + fr; const int R = R0 + ai * 128 + m * 16; const int tt = R & 2047;
                float o[8];
#pragma unroll
                for (int n = 0; n < 2; ++n)
#pragma unroll
                    for (int e = 0; e < 4; ++e) { const float xc = acc[ai][0][m][n][e]; const float xp = (m == 0) ? H[n][e] : acc[ai][0][m > 0 ? m - 1 : 0][n][e];
                        const float s1 = dppf<0x111>(xc), r1 = dppf<0x121>(xp), s2 = dppf<0x112>(xc), r2 = dppf<0x122>(xp);
                        float p1 = (fr >= 1) ? s1 : r1, p2 = (fr >= 2) ? s2 : r2;
                        if (tt < 1) p1 = 0.f;
                        if (tt < 2) p2 = 0.f;
                        o[4 * n + e] = w2[n][e] * xc + w1[n][e] * p1 + w0[n][e] * p2 + bb[n][e]; }
                if (tr >= 2 && R < MTOK) {
                    const f32x2 g0 = pg8::gelu_pk((f32x2){o[0], o[1]}), g1 = pg8::gelu_pk((f32x2){o[2], o[3]}), g2 = pg8::gelu_pk((f32x2){o[4], o[5]}), g3 = pg8::gelu_pk((f32x2){o[6], o[7]});
                    const f32x4 v0 = acc[ai][1][m][0], v1 = acc[ai][1][m][1];
                    u32x4 w; w.x = pk2(g0.x * v0[0], g0.y * v0[1]); w.y = pk2(g1.x * v0[2], g1.y * v0[3]); w.z = pk2(g2.x * v1[0], g2.y * v1[1]); w.w = pk2(g3.x * v1[2], g3.y * v1[3]);
                    *(u32x4*)(y + (size_t)R * FFD + gch) = w; } } }
    }
};

struct EpiDown {
    const bf16_t* x1b; float* out;
    __device__ __forceinline__ void operator()(AccRef acc, const Unit& u, int wr, int wc, int fr, int fq) const {
        const int rbase = u.pm * 256 + wr * 64 + fr, c0 = u.pn * 256 + wc * 32 + 8 * fq;
#pragma unroll
        for (int ai = 0; ai < 2; ++ai)
#pragma unroll
            for (int m = 0; m < 4; ++m) { const size_t r = (size_t)(rbase + ai * 128 + m * 16);
#pragma unroll
                for (int bj = 0; bj < 2; ++bj) { const size_t o = r * 1024 + c0 + bj * 128; const u32x4 xw = *(const u32x4*)(x1b + o);
                    f32x4 v0 = acc[ai][bj][m][0], v1 = acc[ai][bj][m][1];
                    v0[0] += bflo(xw.x); v0[1] += bfhi(xw.x); v0[2] += bflo(xw.y); v0[3] += bfhi(xw.y); v1[0] += bflo(xw.z); v1[1] += bfhi(xw.z); v1[2] += bflo(xw.w); v1[3] += bfhi(xw.w);
                    *(f32x4*)(out + o) = v0; *(f32x4*)(out + o + 4) = v1; } }
    }
};

__device__ __forceinline__ void transpose_item(const float* W, int ldw, int K, bf16_t* WT, int n0, int sc0, int k0, const float* ksc, LAS float* scr, int lane) {
#pragma unroll
    for (int i = 0; i < 32; ++i) { const int kk = 2 * i + (lane >> 5); float w = W[(size_t)(k0 + kk) * ldw + sc0 + (lane & 31)]; if (ksc) w *= ksc[k0 + kk]; scr[kk * 33 + (lane & 31)] = w; }
    asm volatile("s_waitcnt lgkmcnt(0)" ::: "memory");
    const int c = lane & 7;
#pragma unroll
    for (int j = 0; j < 4; ++j) { const int n = (lane >> 3) + 8 * j; const LAS float* s = scr + (8 * c) * 33 + n;
        u32x4 o; o.x = pk2(s[0 * 33], s[1 * 33]); o.y = pk2(s[2 * 33], s[3 * 33]); o.z = pk2(s[4 * 33], s[5 * 33]); o.w = pk2(s[6 * 33], s[7 * 33]);
        *(u32x4*)(WT + (size_t)(n0 + n) * K + k0 + 8 * c) = o; }
    asm volatile("s_waitcnt lgkmcnt(0)" ::: "memory");
}

struct Params {
    const float* in[22]; float* out; unsigned char* ws;
};

template <bool FF> __device__ __forceinline__ void norm_rows(const float* xbase, int nrows, int gw, int NGW, const float* g, bf16_t* obase, const LAS float* ffw, const float* fbias, float* flog, int lane) {
    f32x4 gr[4];
#pragma unroll
    for (int j = 0; j < 4; ++j) gr[j] = ((const f32x4*)g)[lane + 64 * j];
    f32x4 nv[2][4];
#pragma unroll
    for (int r = 0; r < 2; ++r) { const int m = gw + r * NGW; const int mc = m < nrows ? m : nrows - 1;
#pragma unroll
        for (int j = 0; j < 4; ++j) nv[r][j] = ((const f32x4*)(xbase + (size_t)mc * DM))[lane + 64 * j]; }
    for (int m0 = gw; m0 < nrows; m0 += 2 * NGW) {
        f32x4 v[2][4]; float s[2];
#pragma unroll
        for (int r = 0; r < 2; ++r) { s[r] = 0.f;
#pragma unroll
            for (int j = 0; j < 4; ++j) { v[r][j] = nv[r][j]; s[r] += (v[r][j][0] * v[r][j][0] + v[r][j][1] * v[r][j][1]) + (v[r][j][2] * v[r][j][2] + v[r][j][3] * v[r][j][3]); } }
#pragma unroll
        for (int r = 0; r < 2; ++r) { const int m = m0 + (2 + r) * NGW; const int mc = m < nrows ? m : nrows - 1;
#pragma unroll
            for (int j = 0; j < 4; ++j) nv[r][j] = ((const f32x4*)(xbase + (size_t)mc * DM))[lane + 64 * j]; }
        s[0] = xsum64(s[0]); s[1] = xsum64(s[1]);
        float dd[2][8];
#pragma unroll
        for (int r = 0; r < 2; ++r) { const int m = m0 + r * NGW; const bool ok = m < nrows;
            const float rstd = __builtin_amdgcn_rsqf(s[r] * (1.f / DM) + EPS);
#pragma unroll
            for (int j = 0; j < 4; ++j) v[r][j] = v[r][j] * rstd * gr[j];
            if (ok) { u32x2* o8 = (u32x2*)(obase + (size_t)m * DM) + lane;
#pragma unroll
                for (int j = 0; j < 4; ++j) { u32x2 w; w.x = pk2(v[r][j][0], v[r][j][1]); w.y = pk2(v[r][j][2], v[r][j][3]); o8[64 * j] = w; } } }
        if (FF) {
#pragma unroll
            for (int jj = 0; jj < 8; ++jj) { float t0 = 0.f, t1 = 0.f;
#pragma unroll
                for (int j = 0; j < 4; ++j) { const f32x4 w = *(const LAS f32x4*)(ffw + jj * 1024 + 4 * (lane + 64 * j));
                    t0 += v[0][j][0] * w[0] + v[0][j][1] * w[1] + v[0][j][2] * w[2] + v[0][j][3] * w[3]; t1 += v[1][j][0] * w[0] + v[1][j][1] * w[1] + v[1][j][2] * w[2] + v[1][j][3] * w[3]; }
                dd[0][jj] = t0; dd[1][jj] = t1; }
            const bool b5 = (lane & 32) != 0, b4 = (lane & 16) != 0, b3 = (lane & 8) != 0;
            float rr[2];
#pragma unroll
            for (int r = 0; r < 2; ++r) { float k4[4], k2[2];
#pragma unroll
                for (int j = 0; j < 4; ++j) { const float snd = b5 ? dd[r][j] : dd[r][j + 4], kp = b5 ? dd[r][j + 4] : dd[r][j]; k4[j] = kp + sxor<32>(snd); }
#pragma unroll
                for (int j = 0; j < 2; ++j) { const float snd = b4 ? k4[j] : k4[j + 2], kp = b4 ? k4[j + 2] : k4[j]; k2[j] = kp + sxor<16>(snd); }
                { const float snd = b3 ? k2[0] : k2[1], kp = b3 ? k2[1] : k2[0]; rr[r] = kp + sxor<8>(snd); }
                rr[r] += sxor<4>(rr[r]); rr[r] += sxor<2>(rr[r]); rr[r] += sxor<1>(rr[r]); }
            if ((lane & 7) == 0) { const int jj = lane >> 3;
#pragma unroll
                for (int r = 0; r < 2; ++r) { const int m = m0 + r * NGW; if (m < nrows) { const float zz = rr[r] + fbias[jj]; flog[(size_t)m * 8 + jj] = fminf(zz, 0.f) - log1pf(__expf(-fabsf(zz))); } } }
        }
    }
}

typedef float f32x16 __attribute__((ext_vector_type(16)));
__device__ __forceinline__ float swapmax(float v) { auto rr = __builtin_amdgcn_permlane32_swap(__float_as_uint(v), __float_as_uint(v), false, false); const unsigned a = rr[0], b = rr[1]; return fmaxf(__uint_as_float(a), __uint_as_float(b)); }
__device__ __forceinline__ float swapsum(float v) { auto rr = __builtin_amdgcn_permlane32_swap(__float_as_uint(v), __float_as_uint(v), false, false); const unsigned a = rr[0], b = rr[1]; return __uint_as_float(a) + __uint_as_float(b); }
template <int D, bool FOX, int KS, int VS>
__device__ __forceinline__ void attn_tile(const LAS bf16_t* Ks, const LAS bf16_t* Vs, const bf16x8 (&qf)[D / 16], const bf16x8 qx, f32x16 (&O)[D / 32], float& mrow, float& lrow,
                                          int k0, int q0w, int r32, int hi) {
    f32x16 s[2];
#pragma unroll
    for (int kb = 0; kb < 2; ++kb) {
#pragma unroll
        for (int j = 0; j < 16; ++j) s[kb][j] = 0.f;
#pragma unroll
        for (int ks = 0; ks < D / 16; ++ks) { const bf16x8 kf = *(const LAS bf16x8*)(Ks + (32 * kb + r32) * KS + 16 * ks + 8 * hi);
            s[kb] = __builtin_amdgcn_mfma_f32_32x32x16_bf16(kf, qf[ks], s[kb], 0, 0, 0); }
        if (FOX) {
            const bf16x8 kx = *(const LAS bf16x8*)(Ks + (32 * kb + r32) * KS + D + 8 * hi);
            s[kb] = __builtin_amdgcn_mfma_f32_32x32x16_bf16(kx, qx, s[kb], 0, 0, 0); } }
    if (FOX) {
        if (k0 + 63 > q0w) {
#pragma unroll
            for (int kb = 0; kb < 2; ++kb)
#pragma unroll
                for (int j = 0; j < 16; ++j) { const int key = k0 + 32 * kb + 8 * (j >> 2) + 4 * hi + (j & 3); if (key > q0w + r32) s[kb][j] = -1e30f; }
        }
    }
    float mx = fmaxf(s[0][0], s[1][0]);
#pragma unroll
    for (int j = 1; j < 16; ++j) mx = fmaxf(mx, fmaxf(s[0][j], s[1][j]));
    mx = swapmax(mx);
    if (__builtin_amdgcn_ballot_w64(mx > mrow) != 0ull) {
        const float mn = fmaxf(mrow, mx); const float al = __builtin_amdgcn_exp2f(mrow - mn); mrow = mn;
        lrow = lrow * al;
#pragma unroll
        for (int i = 0; i < D / 32; ++i) O[i] = O[i] * al;
    }
    const float mn = mrow;
    float ps = 0.f;
#pragma unroll
    for (int kb = 0; kb < 2; ++kb)
#pragma unroll
        for (int j = 0; j < 16; ++j) { const float p = __builtin_amdgcn_exp2f(s[kb][j] - mn); s[kb][j] = p; ps += p; }
    lrow += ps;
#pragma unroll
    for (int kb = 0; kb < 2; ++kb)
#pragma unroll
        for (int sx = 0; sx < 2; ++sx) { u32x4 pw; pw.x = pk2(s[kb][8 * sx + 0], s[kb][8 * sx + 1]); pw.y = pk2(s[kb][8 * sx + 2], s[kb][8 * sx + 3]); pw.z = pk2(s[kb][8 * sx + 4], s[kb][8 * sx + 5]); pw.w = pk2(s[kb][8 * sx + 6], s[kb][8 * sx + 7]);
            const bf16x8 pf = __builtin_bit_cast(bf16x8, pw);
#pragma unroll
            for (int db = 0; db < D / 32; ++db) { const LAS bf16_t* vp = Vs + (32 * db + r32) * VS + 32 * kb + 16 * sx + 4 * hi;
                const u32x2 lo = *(const LAS u32x2*)vp, hi2 = *(const LAS u32x2*)(vp + 8); const u32x4 vw = {lo.x, lo.y, hi2.x, hi2.y};
                O[db] = __builtin_amdgcn_mfma_f32_32x32x16_bf16(__builtin_bit_cast(bf16x8, vw), pf, O[db], 0, 0, 0); } }
}
template <int D> __device__ __forceinline__ void q_frags(const u32x4 (&qw)[D / 16], const float* qg, float scale, int hi, bf16x8 (&qf)[D / 16]) {
    float ssq = 0.f;
#pragma unroll
    for (int ks = 0; ks < D / 16; ++ks) { const float t0 = bflo(qw[ks].x), t1 = bfhi(qw[ks].x), t2 = bflo(qw[ks].y), t3 = bfhi(qw[ks].y), t4 = bflo(qw[ks].z), t5 = bfhi(qw[ks].z), t6 = bflo(qw[ks].w), t7 = bfhi(qw[ks].w);
        ssq += (t0 * t0 + t1 * t1) + (t2 * t2 + t3 * t3) + (t4 * t4 + t5 * t5) + (t6 * t6 + t7 * t7); }
    ssq = swapsum(ssq);
    const float rs = scale * __builtin_amdgcn_rsqf(ssq * (1.f / D) + EPS);
#pragma unroll
    for (int ks = 0; ks < D / 16; ++ks) { const f32x4 g0 = *(const f32x4*)(qg + 16 * ks + 8 * hi), g1 = *(const f32x4*)(qg + 16 * ks + 8 * hi + 4); u32x4 w;
        w.x = pk2(bflo(qw[ks].x) * rs * g0[0], bfhi(qw[ks].x) * rs * g0[1]); w.y = pk2(bflo(qw[ks].y) * rs * g0[2], bfhi(qw[ks].y) * rs * g0[3]);
        w.z = pk2(bflo(qw[ks].z) * rs * g1[0], bfhi(qw[ks].z) * rs * g1[1]); w.w = pk2(bflo(qw[ks].w) * rs * g1[2], bfhi(qw[ks].w) * rs * g1[3]); qf[ks] = __builtin_bit_cast(bf16x8, w); }
}
template <int D> __device__ __forceinline__ void o_store(const f32x16 (&O)[D / 32], float lrow, bf16_t* orow, int hi) {
    const float linv = __builtin_amdgcn_rcpf(swapsum(lrow));
#pragma unroll
    for (int db = 0; db < D / 32; ++db)
#pragma unroll
        for (int g4 = 0; g4 < 4; g4 += 2) {
            unsigned ax = pk2(O[db][4 * g4] * linv, O[db][4 * g4 + 1] * linv), ay = pk2(O[db][4 * g4 + 2] * linv, O[db][4 * g4 + 3] * linv);
            unsigned bx = pk2(O[db][4 * g4 + 4] * linv, O[db][4 * g4 + 5] * linv), by = pk2(O[db][4 * g4 + 6] * linv, O[db][4 * g4 + 7] * linv);
            { auto r = __builtin_amdgcn_permlane32_swap(ax, bx, false, false); const unsigned r0 = r[0], r1 = r[1]; ax = r0; bx = r1; }
            { auto r = __builtin_amdgcn_permlane32_swap(ay, by, false, false); const unsigned r0 = r[0], r1 = r[1]; ay = r0; by = r1; }
            *(u32x4*)(orow + 32 * db + 8 * g4 + (hi ? 8 : 0)) = (u32x4){ax, ay, bx, by}; }
}
__device__ __forceinline__ void o_store_lds64(const f32x16 (&O)[2], float lrow, bf16_t* obase  , int ldo, LAS bf16_t* stg, int r32, int hi, int lane) {
    constexpr int SS_ = 72;
    const float linv = __builtin_amdgcn_rcpf(swapsum(lrow));
#pragma unroll
    for (int db = 0; db < 2; ++db)
#pragma unroll
        for (int g4 = 0; g4 < 4; ++g4) { u32x2 w; w.x = pk2(O[db][4 * g4] * linv, O[db][4 * g4 + 1] * linv); w.y = pk2(O[db][4 * g4 + 2] * linv, O[db][4 * g4 + 3] * linv);
            *(LAS u32x2*)(stg + r32 * SS_ + 32 * db + 8 * g4 + 4 * hi) = w; }
    asm volatile("s_waitcnt lgkmcnt(0)" ::: "memory");
#pragma unroll
    for (int i = 0; i < 4; ++i) { const int row = (lane >> 3) + 8 * i, ch = lane & 7; const u32x4 v = *(const LAS u32x4*)(stg + row * SS_ + 8 * ch);
        *(u32x4*)(obase + (size_t)row * ldo + 8 * ch) = v; }
}

template <int D> __device__ __forceinline__ u32x4 knorm_chunk(const u32x4 w, const float (&kgr)[8]) {
    constexpr int NKC = D / 8; float t[8];
    t[0] = bflo(w.x); t[1] = bfhi(w.x); t[2] = bflo(w.y); t[3] = bfhi(w.y); t[4] = bflo(w.z); t[5] = bfhi(w.z); t[6] = bflo(w.w); t[7] = bfhi(w.w);
    float sq = (t[0] * t[0] + t[1] * t[1]) + (t[2] * t[2] + t[3] * t[3]) + (t[4] * t[4] + t[5] * t[5]) + (t[6] * t[6] + t[7] * t[7]);
    sq += sxor<1>(sq); sq += sxor<2>(sq); sq += sxor<4>(sq); if (NKC == 16) sq += sxor<8>(sq);
    const float rs = __builtin_amdgcn_rsqf(sq * (1.f / D) + EPS);
    u32x4 o4; o4.x = pk2(t[0] * rs * kgr[0], t[1] * rs * kgr[1]); o4.y = pk2(t[2] * rs * kgr[2], t[3] * rs * kgr[3]); o4.z = pk2(t[4] * rs * kgr[4], t[5] * rs * kgr[5]); o4.w = pk2(t[6] * rs * kgr[6], t[7] * rs * kgr[7]);
    return o4;
}

__device__ __forceinline__ void fox_unit(LAS unsigned char* lds, const bf16_t* Qp, const bf16_t* Kp, const bf16_t* Vt, const float* qg, const float* kg, const float* Fc, int q0, int nkt, const int* ktab, bf16_t* Op, const int wv) {
    constexpr int D = 64, KS = D + 16 + 8, VS = 72, ldq = 512, ldk = 512, ldvt = 2048, ldo = 512, NB = 5;
    constexpr int BUFB = 64 * KS * 2 + D * VS * 2;
    constexpr float L2E = 1.4426950408889634f;
    const int tid = tid_from(wv);
    const int wid = wv, lane = tid & 63, r32 = lane & 31, hi = lane >> 5;
    const int q0w = q0 + wid * 32, tq = q0 >> 6, dw = tq + (wid >> 1);
    const int kt0 = __builtin_amdgcn_readfirstlane(ktab[q0 >> 5]), ktw = __builtin_amdgcn_readfirstlane(ktab[q0w >> 5]);
    int nsteps = 0;
#pragma unroll
    for (int w = 0; w < 8; ++w) { const int n = tq + (w >> 1) - __builtin_amdgcn_readfirstlane(ktab[(q0 >> 5) + w]) + 1; nsteps = n > nsteps ? n : nsteps; }
    bf16x8 qf[4];
    { const bf16_t* qrow = Qp + (size_t)(q0w + r32) * ldq + 8 * hi;
#pragma unroll
      for (int ks = 0; ks < 4; ++ks) qf[ks] = *(const bf16x8*)(qrow + 16 * ks); }
    bf16x8 qx;
    { const float F = Fc[q0w + r32] * L2E; const unsigned c1 = f2bf(F); const float r1 = F - bf1((bf16_t)c1); const unsigned c2 = f2bf(r1); const float r2 = r1 - bf1((bf16_t)c2); const unsigned c3 = f2bf(r2);
      u32x4 w = {c1 | (c2 << 16), c3 | (0x3f80u << 16), 0x3f80u | (0x3f80u << 16), 0u}; if (hi) w = (u32x4){0u, 0u, 0u, 0u}; qx = __builtin_bit_cast(bf16x8, w); }
    f32x16 O[2];
#pragma unroll
    for (int i = 0; i < 2; ++i)
#pragma unroll
        for (int j = 0; j < 16; ++j) O[i][j] = 0.f;
    float mrow = -1e30f, lrow = 0.f;
    const int key = tid >> 3, dc = tid & 7;
#define FOX_LOAD(kr, vr, fr_, kt) do { kr = *(const u32x4*)(Kp + (size_t)((kt) * 64 + key) * ldk + 8 * dc); vr = *(const u32x4*)(Vt + (size_t)key * ldvt + (kt) * 64 + 8 * dc); \
        if (tid < 64) fr_ = Fc[(kt) * 64 + tid] * L2E; } while (0)
#define FOX_STAGE(kr, vr, fr_, kt) do { LAS bf16_t* Ks_ = (LAS bf16_t*)(lds + ((kt) % NB) * BUFB); LAS bf16_t* Vs_ = Ks_ + 64 * KS; \
        *(LAS u32x4*)(Ks_ + key * KS + 8 * dc) = kr; *(LAS u32x4*)(Vs_ + key * VS + 8 * dc) = vr; \
        if (tid < 64) { const float F = fr_; const unsigned c1 = f2bf(F); const float r1 = F - bf1((bf16_t)c1); const unsigned c2 = f2bf(r1); const float r2 = r1 - bf1((bf16_t)c2); const unsigned c3 = f2bf(r2); \
            *(LAS u32x4*)(Ks_ + tid * KS + D) = (u32x4){0x3f80u | (0x3f80u << 16), 0x3f80u | ((c1 ^ 0x8000u) << 16), (c2 ^ 0x8000u) | ((c3 ^ 0x8000u) << 16), 0u}; \
            *(LAS u32x4*)(Ks_ + tid * KS + D + 8) = (u32x4){0u, 0u, 0u, 0u}; } } while (0)
    {
        u32x4 k4[4], v4[4]; float f4[4] = {0.f, 0.f, 0.f, 0.f};
#pragma unroll
        for (int j = 0; j < 4; ++j) FOX_LOAD(k4[j], v4[j], f4[j], tq + 3 - j);
#pragma unroll
        for (int j = 0; j < 4; ++j) FOX_STAGE(k4[j], v4[j], f4[j], tq + 3 - j);
    }
    u32x4 kreg, vreg; float fkreg = 0.f;
    if (tq - 1 >= kt0) FOX_LOAD(kreg, vreg, fkreg, tq - 1);
    __syncthreads();
    for (int i = 0; i < nsteps; ++i) {
        const int tl = tq - 1 - i;
        if (tl >= kt0) { FOX_STAGE(kreg, vreg, fkreg, tl); if (tl - 1 >= kt0) FOX_LOAD(kreg, vreg, fkreg, tl - 1); }
        const int t = dw - i;
        if (t >= ktw) {
            const LAS bf16_t* Ks = (const LAS bf16_t*)(lds + (t % NB) * BUFB); const LAS bf16_t* Vs = Ks + 64 * KS;
            attn_tile<64, true, KS, VS>(Ks, Vs, qf, qx, O, mrow, lrow, t * 64, q0w, r32, hi);
        }
        __syncthreads();
    }
#undef FOX_LOAD
#undef FOX_STAGE
    o_store_lds64(O, lrow, Op + (size_t)q0w * ldo, ldo, (LAS bf16_t*)(lds + wid * 4608), r32, hi, lane);
}

__device__ __forceinline__ void mem_unit(LAS unsigned char* lds, const bf16_t* Qp, const bf16_t* Kp, const bf16_t* Vt, const float* qg, const float* kg, bf16_t* Op, const int wv) {
    constexpr int D = 128, KS = D + 8, VS = 264, ldq = 512, ldk = 512, ldvt = 256, ldo = 512;
    constexpr float L2E = 1.4426950408889634f;
    const int tid = tid_from(wv);
    const int wid = wv, lane = tid & 63, r32 = lane & 31, hi = lane >> 5;
    LAS bf16_t* Ks = (LAS bf16_t*)lds; LAS bf16_t* Vs = Ks + 256 * KS;
    bf16x8 qw[8];
    { const bf16_t* qrow = Qp + (size_t)(wid * 32 + r32) * ldq + 8 * hi;
#pragma unroll
      for (int ks = 0; ks < 8; ++ks) qw[ks] = *(const bf16x8*)(qrow + 16 * ks); }
    {
#pragma unroll
      for (int rnd = 0; rnd < 2; ++rnd) { u32x4 kr[4], vr[4];
#pragma unroll
          for (int i = 0; i < 4; ++i) { const int ci = tid + 512 * (4 * rnd + i); const int key = ci >> 4, dc = ci & 15; kr[i] = *(const u32x4*)(Kp + (size_t)key * ldk + 8 * dc);
              const int d = ci >> 5, kc = ci & 31; vr[i] = *(const u32x4*)(Vt + (size_t)d * ldvt + 8 * kc); }
#pragma unroll
          for (int i = 0; i < 4; ++i) { const int ci = tid + 512 * (4 * rnd + i); const int key = ci >> 4, dc = ci & 15; *(LAS u32x4*)(Ks + key * KS + 8 * dc) = kr[i];
              const int d = ci >> 5, kc = ci & 31; *(LAS u32x4*)(Vs + d * VS + 8 * kc) = vr[i]; } } }
    __syncthreads();
    for (int qb = 0; qb < 4; ++qb) {
        bf16x8 qf[8];
#pragma unroll
        for (int ks = 0; ks < 8; ++ks) qf[ks] = qw[ks];
        if (qb + 1 < 4) { const bf16_t* qrow = Qp + (size_t)((qb + 1) * 256 + wid * 32 + r32) * ldq + 8 * hi;
#pragma unroll
            for (int ks = 0; ks < 8; ++ks) qw[ks] = *(const bf16x8*)(qrow + 16 * ks); }
        f32x16 O[4];
#pragma unroll
        for (int i = 0; i < 4; ++i)
#pragma unroll
            for (int j = 0; j < 16; ++j) O[i][j] = 0.f;
        float mrow = -1e30f, lrow = 0.f;
#pragma unroll 1
        for (int kt = 0; kt < 4; ++kt) attn_tile<128, false, KS, VS>(Ks + kt * 64 * KS, Vs + kt * 64, qf, qf[0], O, mrow, lrow, 0, 0, r32, hi);
        o_store<128>(O, lrow, Op + (size_t)(qb * 256 + wid * 32 + r32) * ldo, hi);
    }
    __syncthreads();
}

__device__ __forceinline__ void hgrn_unit(LAS unsigned char* lds, const bf16_t* hq, const bf16_t* hlf, const bf16_t* hi, const bf16_t* hg, const float* ng, bf16_t* ya, int b, int h, const int wv) {
    constexpr int QS = 136, TS = 72, OS = 132;
    LAS bf16_t* QD = (LAS bf16_t*)lds;
    LAS bf16_t* KD = QD + 64 * QS;
    LAS bf16_t* KDT = KD + 64 * QS;
    LAS bf16_t* IT = KDT + 128 * TS;
    LAS bf16_t* AM = IT + 128 * TS;
    LAS float* DV = (LAS float*)(AM + 64 * TS);
    LAS float* SEG = DV + 128;
    LAS float* OB = SEG + 512;
    const int tid = tid_from(wv);
    const int wid = wv, lane = tid & 63, fr = lane & 15, g = lane >> 4;
    const int c = tid & 127, sg = tid >> 7;
    const size_t rowbase = (size_t)b * NT;
    const size_t cbase = rowbase * 512 + h * 128 + c;
    f32x4 S[8];
#pragma unroll
    for (int i = 0; i < 8; ++i) S[i] = (f32x4){0.f, 0.f, 0.f, 0.f};
    bf16_t rq[16], rf[16], ri[16];
#pragma unroll
    for (int tt = 0; tt < 16; ++tt) { const size_t o = cbase + (size_t)(sg * 16 + tt) * 512; rq[tt] = hq[o]; rf[tt] = hlf[o]; ri[tt] = hi[o]; }
    for (int ch = 0; ch < NT / 64; ++ch) {
        float Gl[16]; float run = 0.f;
#pragma unroll
        for (int tt = 0; tt < 16; ++tt) { run += bf1(rf[tt]); Gl[tt] = run; }
        SEG[sg * 128 + c] = run;
        __syncthreads();
        float pre = 0.f, tot = 0.f;
#pragma unroll
        for (int s4 = 0; s4 < 4; ++s4) { const float v = SEG[s4 * 128 + c]; tot += v; if (s4 < sg) pre += v; }
        if (sg == 0) DV[c] = __expf(tot);
        unsigned kp[8], ip[8];
#pragma unroll
        for (int tt = 0; tt < 16; ++tt) { const float G = pre + Gl[tt]; const float qd = bf1(rq[tt]) * __expf(G); const float kd = (1.f - __expf(bf1(rf[tt]))) * __expf(-G);
            const unsigned qb = f2bf_hw(qd), kb = f2bf_hw(kd);
            QD[(16 * sg + tt) * QS + c] = (bf16_t)qb; KD[(16 * sg + tt) * QS + c] = (bf16_t)kb;
            if (tt & 1) { kp[tt >> 1] |= kb << 16; ip[tt >> 1] |= (unsigned)ri[tt] << 16; } else { kp[tt >> 1] = kb; ip[tt >> 1] = (unsigned)ri[tt]; } }
        *(LAS u32x4*)(KDT + c * TS + 16 * sg) = (u32x4){kp[0], kp[1], kp[2], kp[3]}; *(LAS u32x4*)(KDT + c * TS + 16 * sg + 8) = (u32x4){kp[4], kp[5], kp[6], kp[7]};
        *(LAS u32x4*)(IT + c * TS + 16 * sg) = (u32x4){ip[0], ip[1], ip[2], ip[3]}; *(LAS u32x4*)(IT + c * TS + 16 * sg + 8) = (u32x4){ip[4], ip[5], ip[6], ip[7]};
        if (ch + 1 < NT / 64) {
#pragma unroll
            for (int tt = 0; tt < 16; ++tt) { const size_t o = cbase + (size_t)((ch + 1) * 64 + sg * 16 + tt) * 512; rq[tt] = hq[o]; rf[tt] = hlf[o]; ri[tt] = hi[o]; }
        }
        __syncthreads();
        const size_t goff = (rowbase + ch * 64 + (tid >> 3)) * 512 + h * 128 + 16 * (tid & 7);
        const u32x4 g0 = *(const u32x4*)(hg + goff), g1 = *(const u32x4*)(hg + goff + 8);
#pragma unroll
        for (int bi = 0; bi < 2; ++bi) { const int idx = 2 * wid + bi, tb = idx >> 2, sb = idx & 3;
            f32x4 a = (f32x4){0.f, 0.f, 0.f, 0.f};
            if (sb <= tb) {
#pragma unroll
                for (int ks = 0; ks < 4; ++ks) { const bf16x8 qa = *(const LAS bf16x8*)(QD + (16 * tb + fr) * QS + 32 * ks + 8 * g); const bf16x8 kb = *(const LAS bf16x8*)(KD + (16 * sb + fr) * QS + 32 * ks + 8 * g);
                    a = __builtin_amdgcn_mfma_f32_16x16x32_bf16(qa, kb, a, 0, 0, 0); }
            }
#pragma unroll
            for (int e = 0; e < 4; ++e) { const int t = 16 * tb + 4 * g + e, sx = 16 * sb + fr; AM[t * TS + sx] = (bf16_t)f2bf_hw((sx <= t) ? a[e] : 0.f); } }
        __syncthreads();
        bf16x8 itf[2];
#pragma unroll
        for (int k2 = 0; k2 < 2; ++k2) itf[k2] = *(const LAS bf16x8*)(IT + (16 * wid + fr) * TS + 32 * k2 + 8 * g);
        bf16x8 sbf[4];
#pragma unroll
        for (int m4 = 0; m4 < 4; ++m4) { u32x4 w; w.x = pk2(S[2 * m4][0], S[2 * m4][1]); w.y = pk2(S[2 * m4][2], S[2 * m4][3]); w.z = pk2(S[2 * m4 + 1][0], S[2 * m4 + 1][1]); w.w = pk2(S[2 * m4 + 1][2], S[2 * m4 + 1][3]); sbf[m4] = __builtin_bit_cast(bf16x8, w); }
#pragma unroll
        for (int tb = 0; tb < 4; ++tb) { f32x4 O = (f32x4){0.f, 0.f, 0.f, 0.f};
#pragma unroll
            for (int k2 = 0; k2 < 2; ++k2) { const bf16x8 am = *(const LAS bf16x8*)(AM + (16 * tb + fr) * TS + 32 * k2 + 8 * g); O = __builtin_amdgcn_mfma_f32_16x16x32_bf16(am, itf[k2], O, 0, 0, 0); }
#pragma unroll
            for (int m4 = 0; m4 < 4; ++m4) { const u32x2 lo = *(const LAS u32x2*)(QD + (16 * tb + fr) * QS + 32 * m4 + 4 * g), hi2 = *(const LAS u32x2*)(QD + (16 * tb + fr) * QS + 32 * m4 + 16 + 4 * g);
                const u32x4 w = {lo.x, lo.y, hi2.x, hi2.y}; O = __builtin_amdgcn_mfma_f32_16x16x32_bf16(__builtin_bit_cast(bf16x8, w), sbf[m4], O, 0, 0, 0); }
#pragma unroll
            for (int e = 0; e < 4; ++e) OB[(16 * tb + 4 * g + e) * OS + 16 * wid + fr] = O[e]; }
#pragma unroll
        for (int blk = 0; blk < 8; ++blk) {
#pragma unroll
            for (int k2 = 0; k2 < 2; ++k2) { const bf16x8 kt = *(const LAS bf16x8*)(KDT + (16 * blk + fr) * TS + 32 * k2 + 8 * g); S[blk] = __builtin_amdgcn_mfma_f32_16x16x32_bf16(kt, itf[k2], S[blk], 0, 0, 0); }
            const f32x4 dvv = *(const LAS f32x4*)(DV + 16 * blk + 4 * g); S[blk] = S[blk] * dvv; }
        __syncthreads();
        { const int t = tid >> 3, part = tid & 7; const LAS float* op = OB + t * OS + 16 * part;
            const f32x4 o0 = *(const LAS f32x4*)op, o1 = *(const LAS f32x4*)(op + 4), o2 = *(const LAS f32x4*)(op + 8), o3 = *(const LAS f32x4*)(op + 12);
            float sq = (o0[0] * o0[0] + o0[1] * o0[1] + o0[2] * o0[2] + o0[3] * o0[3]) + (o1[0] * o1[0] + o1[1] * o1[1] + o1[2] * o1[2] + o1[3] * o1[3])
                     + (o2[0] * o2[0] + o2[1] * o2[1] + o2[2] * o2[2] + o2[3] * o2[3]) + (o3[0] * o3[0] + o3[1] * o3[1] + o3[2] * o3[2] + o3[3] * o3[3]);
            sq += sxor<1>(sq); sq += sxor<2>(sq); sq += sxor<4>(sq);
            const float rs = __builtin_amdgcn_rsqf(sq * (1.f / 128.f) + EPS);
            const size_t off = (rowbase + ch * 64 + t) * 512 + h * 128 + 16 * part;
            const f32x4 n0 = *(const f32x4*)(ng + 16 * part), n1 = *(const f32x4*)(ng + 16 * part + 4), n2 = *(const f32x4*)(ng + 16 * part + 8), n3 = *(const f32x4*)(ng + 16 * part + 12);
            u32x4 w0, w1;
            w0.x = pk2(o0[0] * rs * n0[0] * bflo(g0.x), o0[1] * rs * n0[1] * bfhi(g0.x)); w0.y = pk2(o0[2] * rs * n0[2] * bflo(g0.y), o0[3] * rs * n0[3] * bfhi(g0.y));
            w0.z = pk2(o1[0] * rs * n1[0] * bflo(g0.z), o1[1] * rs * n1[1] * bfhi(g0.z)); w0.w = pk2(o1[2] * rs * n1[2] * bflo(g0.w), o1[3] * rs * n1[3] * bfhi(g0.w));
            w1.x = pk2(o2[0] * rs * n2[0] * bflo(g1.x), o2[1] * rs * n2[1] * bfhi(g1.x)); w1.y = pk2(o2[2] * rs * n2[2] * bflo(g1.y), o2[3] * rs * n2[3] * bfhi(g1.y));
            w1.z = pk2(o3[0] * rs * n3[0] * bflo(g1.z), o3[1] * rs * n3[1] * bfhi(g1.z)); w1.w = pk2(o3[2] * rs * n3[2] * bflo(g1.w), o3[3] * rs * n3[3] * bfhi(g1.w));
            *(u32x4*)(ya + off) = w0; *(u32x4*)(ya + off + 8) = w1; }
    }
    __syncthreads();
}

__device__ __forceinline__ void grid_bar(unsigned* cnt, unsigned target, const int wv) {
    __syncthreads();
    if (tid_from(wv) == 0) {
        unsigned* flag = cnt + 32;
        const unsigned gen = target / gridDim.x;
        __builtin_amdgcn_fence(__ATOMIC_RELEASE, "agent");
        const unsigned old = __hip_atomic_fetch_add(cnt, 1u, __ATOMIC_RELAXED, __HIP_MEMORY_SCOPE_AGENT);
        if (old == target - 1u) __hip_atomic_store(flag, gen, __ATOMIC_RELAXED, __HIP_MEMORY_SCOPE_AGENT);
        else while (__hip_atomic_load(flag, __ATOMIC_RELAXED, __HIP_MEMORY_SCOPE_AGENT) < gen) __builtin_amdgcn_s_sleep(4);
        __builtin_amdgcn_fence(__ATOMIC_ACQUIRE, "agent");
    }
    __syncthreads();
}

__global__ void __launch_bounds__(512, 2) fwd_mega(Params P) {
    extern __shared__ __attribute__((aligned(16))) unsigned char lds_raw[];
    LAS unsigned char* lds = (LAS unsigned char*)lds_raw;
    cg::grid_group grid = cg::this_grid();
    const int wv = __builtin_amdgcn_readfirstlane((int)threadIdx.x >> 6);
#define tid (tid_from(wv))
#define lane (lane_id())
#define wid wv
    const int G = gridDim.x, bx = blockIdx.x;
#define ws (P.ws)
#define x (P.in[0])
#define mem (P.in[1])
#define norm_mix_g (P.in[2])
#define norm_mem_g (P.in[3])
#define w_in (P.in[4])
#define lb_logits (P.in[5])
#define hgrn_norm_g (P.in[6])
#define fox_f_bias (P.in[7])
#define fox_q_g (P.in[8])
#define fox_k_g (P.in[9])
#define mem_kv_w (P.in[10])
#define mem_q_g (P.in[11])
#define mem_k_g (P.in[12])
#define w_br_h (P.in[13])
#define w_br_f (P.in[14])
#define w_br_m (P.in[15])
#define w_out (P.in[16])
#define norm_ffn_g (P.in[17])
#define w_up (P.in[18])
#define conv_w (P.in[19])
#define conv_b (P.in[20])
#define w_down (P.in[21])
#define out (P.out)
#define ctl ((unsigned*)(ws + WS_CTL * MiB))
#define WCAT ((bf16_t*)(ws + WS_WCAT * MiB))
#define WBR ((bf16_t*)(ws + WS_WBR * MiB))
#define WOUT ((bf16_t*)(ws + WS_WOUT * MiB))
#define WUP ((bf16_t*)(ws + WS_WUP * MiB))
#define WDOWN ((bf16_t*)(ws + WS_WDOWN * MiB))
#define FLOG ((float*)(ws + WS_FLOG * MiB))
#define FC ((float*)(ws + WS_FC * MiB))
#define SS ((float*)(ws + WS_SS * MiB))
#define MEMK ((bf16_t*)(ws + WS_MEMK * MiB))
#define MEMVT ((bf16_t*)(ws + WS_MEMVT * MiB))
#define Z ((bf16_t*)(ws + WS_Z * MiB))
#define GATES ((bf16_t*)(ws + WS_GATES * MiB))
#define ACC32 ((float*)(ws + WS_ACC32 * MiB))
#define MERGED ((bf16_t*)(ws + WS_MERGED * MiB))
#define X1B ((bf16_t*)(ws + WS_X1B * MiB))
#define Y ((bf16_t*)(ws + WS_Y * MiB))
#define HCAT ((bf16_t*)out)
#define YABC ((bf16_t*)out)
    const size_t ZS = (size_t)MTOK * 512;

#ifndef NO_P0
#ifdef DUP_P0
    for (int rep0 = 0; rep0 < 2; ++rep0)
#endif
    {
        if (bx == 0 && tid == 0) { ctl[0] = 0u; ctl[1] = 0u; ctl[64] = 0u; ctl[96] = 0u; }
        if (bx == 0 && tid < 384) { const int t_ = tid; float* gt = (float*)(ctl + 2048); gt[t_] = t_ < 64 ? fox_q_g[t_] : (t_ < 128 ? fox_k_g[t_ - 64] : (t_ < 256 ? mem_q_g[t_ - 128] : mem_k_g[t_ - 256])); }
        LAS float* ffw = (LAS float*)(lds + 73728);
        for (int idx = tid; idx < 8192; idx += 512) { const int k = idx >> 3, jj = idx & 7; ffw[jj * 1024 + k] = w_in[(size_t)k * INC + 3584 + jj]; }
        __syncthreads();
        LAS float* scr = (LAS float*)(lds + wid * 8448);
        const int gw = bx * 8 + wid, NGW = G * 8;
        constexpr int I0 = 16 * 224, I1 = 16 * 32, I2 = 8 * 32, I3 = 16 * 32, I4 = 16 * 176, I5 = 44 * 32;
        constexpr int NIT = I0 + I1 + 3 * I2 + I3 + I4 + I5;
        for (int it = gw; it < NIT; it += NGW) {
            int r = it;
            if (r < I0) { const int kb = r / 224, nb = r % 224, n0 = nb * 32; transpose_item(w_in, INC, 1024, WCAT, n0, n0 < 3584 ? n0 : n0 + 8, kb * 64, nullptr, scr, lane); continue; } r -= I0;
            if (r < I1) { const int kb = r / 32, nb = r % 32; transpose_item(mem_kv_w, 1024, 1024, WCAT + (size_t)7168 * 1024, nb * 32, nb * 32, kb * 64, nullptr, scr, lane); continue; } r -= I1;
            if (r < 3 * I2) { const int j = r / I2, rr = r % I2, kb = rr / 32, nb = rr % 32; const float* W = j == 0 ? w_br_h : (j == 1 ? w_br_f : w_br_m);
                transpose_item(W, 1024, 512, WBR + (size_t)j * 1024 * 512, nb * 32, nb * 32, kb * 64, nullptr, scr, lane); continue; } r -= 3 * I2;
            if (r < I3) { const int kb = r / 32, nb = r % 32; transpose_item(w_out, 1024, 1024, WOUT, nb * 32, nb * 32, kb * 64, nullptr, scr, lane); continue; } r -= I3;
            if (r < I4) { const int kb = r / 176, nb = r % 176, n0 = nb * 32; const int pn = n0 >> 8, bj = (n0 >> 7) & 1, cc = n0 & 127;
                transpose_item(w_up, 2 * FFD, 1024, WUP, n0, bj * FFD + 128 * pn + cc, kb * 64, norm_ffn_g, scr, lane); continue; } r -= I4;
            { const int kb = r / 32, nb = r % 32; transpose_item(w_down, 1024, FFD, WDOWN, nb * 32, nb * 32, kb * 64, nullptr, scr, lane); }
        }
        norm_rows<true>(x, MTOK, gw, NGW, norm_mix_g, HCAT, ffw, fox_f_bias, FLOG, lane);
        norm_rows<false>(mem, MMEM, gw, NGW, norm_mem_g, HCAT + (size_t)MTOK * DM, ffw, nullptr, nullptr, lane);
    }
#endif
    grid.sync();

#ifndef NO_P1
    {
        LAS float* wt = (LAS float*)(lds + LDS_X); LAS float* FcL = (LAS float*)(lds + LDS_X + 1024);
        for (int bh = bx; bh < 256; bh += G) { const int b = bh >> 3, h = bh & 7;
            float v[4]; float run = 0.f;
#pragma unroll
            for (int e = 0; e < 4; ++e) { run += FLOG[((size_t)b * NT + 4 * tid + e) * 8 + h]; v[e] = run; }
            float inc = run;
#pragma unroll
            for (int o = 1; o < 64; o <<= 1) { const int l_ = lane_id(); const float t = __int_as_float(__builtin_amdgcn_ds_bpermute((l_ - o) << 2, __float_as_int(inc))); if (l_ >= o) inc += t; }
            if (lane == 63) wt[wid] = inc;
            __syncthreads();
            float pre = inc - run;
            for (int w = 0; w < wid; ++w) pre += wt[w];
            const f32x4 fc4 = {pre + v[0], pre + v[1], pre + v[2], pre + v[3]};
            *(f32x4*)(FC + (size_t)bh * NT + 4 * tid) = fc4; *(LAS f32x4*)(FcL + 4 * tid) = fc4;
            __syncthreads();
            { float gq = fabsf(fox_q_g[lane]), gk = fabsf(fox_k_g[lane]);
                gq = xmax64(gq); gk = xmax64(gk);
                const float L2 = 2.f * 8.f * 1.02f * gq * gk;
                const int l_ = lane;
                for (int i = 0; i < 8; ++i) { const int rb = 8 * wid + i; bool skip = false;
                    if (l_ < ((rb >> 1) + 1)) skip = (L2 + FcL[32 * rb] - FcL[64 * l_ + 63]) * 1.4426950408889634f < -127.f;
                    const int k0t = __builtin_popcountll(__ballot(skip));
                    if (l_ == 0) ((int*)ctl)[4096 + bh * 64 + rb] = k0t; } }
            __syncthreads();
        }
        SchedIn S{G, bx, (const char*)HCAT, (const char*)WCAT};
        EpiIn E{Z, GATES, MEMK, MEMVT, lb_logits, (const float*)(ctl + 2048), (LAS float*)(lds + LDS_X + 8192)};
#ifdef DUP_P1
        pg8::gemm_phase<EpiIn, SchedIn>(lds, 1024, S, E, wv);
#endif
        pg8::gemm_phase<EpiIn, SchedIn>(lds, 1024, S, E, wv);
    }
#endif
    grid_bar(ctl + 64, 1u * (unsigned)G, wv);

#ifndef NO_P2
    {
        LAS int* slot = (LAS int*)(lds + LDS_BYTES - 64);
#ifdef DUP_P2
        for (int rep = 0; rep < 2; ++rep)
#else
        const int rep = 0;
#endif
        __syncthreads();
        if (tid == 0) *slot = (int)atomicAdd(ctl + rep, 1u);
        for (;;) {
            __syncthreads();
            const int it = *slot;
            if (it >= 128 + 256 + 2048) break;
            unsigned nxt = 0u;
            if (tid == 0) nxt = atomicAdd(ctl + rep, 1u);
            __syncthreads();
            if (it < 128) { hgrn_unit(lds, Z + 0 * ZS, Z + 1 * ZS, Z + 2 * ZS, Z + 3 * ZS, hgrn_norm_g, YABC, it >> 2, it & 3, wv); }
            else if (it < 128 + 256) { const int r = it - 128, half = r & 1, bh = r >> 1, b = bh >> 2, h = bh & 3;
                mem_unit(lds, Z + 7 * ZS + ((size_t)b * NT + half * 1024) * 512 + h * 128, MEMK + (size_t)b * NMEM * 512 + h * 128, MEMVT + (size_t)bh * 128 * 256, mem_q_g, mem_k_g,
                         YABC + 2 * ZS + ((size_t)b * NT + half * 1024) * 512 + h * 128, wv); }
            else { const int r = it - 128 - 256, qb = 7 - (r >> 8), bh = r & 255, b = bh >> 3, h = bh & 7;
                fox_unit(lds, Z + 4 * ZS + (size_t)b * NT * 512 + h * 64, Z + 5 * ZS + (size_t)b * NT * 512 + h * 64, Z + 6 * ZS + (size_t)bh * 64 * 2048, fox_q_g, fox_k_g, FC + (size_t)bh * NT, qb * 256, 4 * (qb + 1), (const int*)ctl + 4096 + bh * 64,
                         YABC + ZS + (size_t)b * NT * 512 + h * 64, wv); }
            if (tid == 0) *slot = (int)nxt;
        }
    }
#endif
    grid_bar(ctl + 64, 2u * (unsigned)G, wv);

#ifndef NO_P3
    for (int p = bx; p < 256; p += G) {
        {
            SchedMerge S{p, (const char*)YABC, (const char*)WBR};
            EpiMerge E{GATES, (bf16_t*)ACC32, MERGED};
            pg8::gemm_phase<EpiMerge, SchedMerge>(lds, 512, S, E, wv);
        }
        __syncthreads();
        {
            SchedPanel S{p, (const char*)MERGED, (const char*)WOUT, 2048};
            EpiOut E{x, X1B, SS, (LAS float*)(lds + LDS_X + 8192), wv};
            pg8::gemm_phase<EpiOut, SchedPanel>(lds, 1024, S, E, wv);
        }
    }
#endif
    grid_bar(ctl + 64, 3u * (unsigned)G, wv);

#ifndef NO_P5
    {
        SchedPlain S{G, bx, 259, 22, 254, -2, (const char*)X1B, (const char*)WUP, 2048};
        EpiUp E{SS, conv_w, conv_b, Y, (LAS float*)(lds + LDS_X + 256)};
#ifdef DUP_P5
        pg8::gemm_phase<EpiUp, SchedPlain>(lds, 1024, S, E, wv);
#endif
        pg8::gemm_phase<EpiUp, SchedPlain>(lds, 1024, S, E, wv);
    }
#endif
    grid_bar(ctl + 64, 4u * (unsigned)G, wv);
#ifdef PROBE_BAR
    grid_bar(ctl + 64, 5u * (unsigned)G, wv); grid_bar(ctl + 64, 6u * (unsigned)G, wv); grid_bar(ctl + 64, 7u * (unsigned)G, wv); grid_bar(ctl + 64, 8u * (unsigned)G, wv); grid_bar(ctl + 64, 9u * (unsigned)G, wv);
#endif

#ifndef NO_P6
    {
        SchedPlain S{G, bx, 256, 4, 256, 0, (const char*)Y, (const char*)WDOWN, 2 * FFD};
        EpiDown E{X1B, out};
        pg8::gemm_phase<EpiDown, SchedPlain>(lds, FFD, S, E, wv);
    }
#endif
}

#undef tid
#undef lane
#undef wid
#undef ws
#undef x
#undef mem
#undef norm_mix_g
#undef norm_mem_g
#undef w_in
#undef lb_logits
#undef hgrn_norm_g
#undef fox_f_bias
#undef fox_q_g
#undef fox_k_g
#undef mem_kv_w
#undef mem_q_g
#undef mem_k_g
#undef w_br_h
#undef w_br_f
#undef w_br_m
#undef w_out
#undef norm_ffn_g
#undef w_up
#undef conv_w
#undef conv_b
#undef w_down
#undef out
#undef ctl
#undef WCAT
#undef WBR
#undef WOUT
#undef WUP
#undef WDOWN
#undef FLOG
#undef FC
#undef SS
#undef MEMK
#undef MEMVT
#undef Z
#undef GATES
#undef ACC32
#undef MERGED
#undef X1B
#undef Y
#undef HCAT
#undef YABC
extern "C" void kernel_launch(void* const* d_in, const int* in_sizes, int n_in, void* d_out, int out_size, void* d_ws, size_t ws_size, hipStream_t stream) {
    static int grid = 0;
    if (grid == 0) {
        int dev = 0, cus = 0, per_cu = 0;
        hipGetDevice(&dev);
        hipDeviceGetAttribute(&cus, hipDeviceAttributeMultiprocessorCount, dev);
        hipFuncSetAttribute((const void*)fwd_mega, hipFuncAttributeMaxDynamicSharedMemorySize, LDS_BYTES);
        hipOccupancyMaxActiveBlocksPerMultiprocessor(&per_cu, (const void*)fwd_mega, 512, LDS_BYTES);
        if (per_cu < 1) per_cu = 1;
        grid = cus * per_cu;
        (void)hipGetLastError();
    }
    Params p{};
    for (int i = 0; i < 22; ++i) p.in[i] = (const float*)d_in[i];
    p.out = (float*)d_out; p.ws = (unsigned char*)d_ws;
    void* args[] = {&p};
    hipError_t e = hipLaunchCooperativeKernel((const void*)fwd_mega, dim3(grid), dim3(512), args, LDS_BYTES, stream);
    if (e != hipSuccess) fprintf(stderr, "cooperative launch failed: %s (grid %d)\n", hipGetErrorString(e), grid);
}
```

```cpp
#include <hip/hip_runtime.h>
#include <hip/hip_cooperative_groups.h>
#include <cstdio>
#include <cstdint>
namespace cg = cooperative_groups;

#define LAS __attribute__((address_space(3)))
typedef unsigned short bf16_t;
typedef short bf16x8 __attribute__((ext_vector_type(8)));
typedef float f32x4 __attribute__((ext_vector_type(4)));
typedef float f32x2 __attribute__((ext_vector_type(2)));
typedef unsigned u32x4 __attribute__((ext_vector_type(4)));
typedef unsigned u32x2 __attribute__((ext_vector_type(2)));

constexpr int NB = 32, NT = 2048, DM = 1024, MTOK = NB * NT, NMEM = 256, MMEM = NB * NMEM;
constexpr int INC = 7176, FFD = 2816;
constexpr float EPS = 1e-6f;
constexpr size_t MiB = 1u << 20;
constexpr size_t WS_CTL = 0, WS_WCAT = 1, WS_WBR = 17, WS_WOUT = 20, WS_WUP = 22, WS_WDOWN = 33, WS_FLOG = 40, WS_FC = 42, WS_SS = 44,
                 WS_MEMK = 48, WS_MEMVT = 56, WS_Z = 64, WS_GATES = 576, WS_ACC32 = 64, WS_MERGED = 320, WS_X1B = 448, WS_Y = 600;
constexpr int LDS_BYTES = 147456;
constexpr int LDS_X = 131072;

__device__ __forceinline__ unsigned f2bf(float f) { unsigned u = __builtin_bit_cast(unsigned, f); return (u + 0x7fffu + ((u >> 16) & 1u)) >> 16; }
typedef __bf16 bf16x2_t __attribute__((ext_vector_type(2)));
__device__ __forceinline__ unsigned pk2(float lo, float hi) { const f32x2 v = {lo, hi}; const bf16x2_t b = __builtin_convertvector(v, bf16x2_t); return __builtin_bit_cast(unsigned, b); }
__device__ __forceinline__ unsigned f2bf_hw(float f) { return pk2(f, 0.f) & 0xffffu; }
__device__ __forceinline__ float bflo(unsigned u) { return __builtin_bit_cast(float, u << 16); }
__device__ __forceinline__ float bfhi(unsigned u) { return __builtin_bit_cast(float, u & 0xffff0000u); }
__device__ __forceinline__ float bf1(bf16_t u) { return __builtin_bit_cast(float, (unsigned)u << 16); }
__device__ __forceinline__ int lane_id() { int l = (int)__builtin_amdgcn_mbcnt_hi(~0u, __builtin_amdgcn_mbcnt_lo(~0u, 0u)); asm volatile("" : "+v"(l)); return l; }
__device__ __forceinline__ int tid_from(int wv) { return wv * 64 + lane_id(); }
template <int O> __device__ __forceinline__ float sxor(float v) {
    if constexpr (O == 32) { auto rr = __builtin_amdgcn_permlane32_swap(__float_as_uint(v), __float_as_uint(v), false, false); const unsigned a = rr[0], b = rr[1]; return (lane_id() & 32) ? __uint_as_float(a) : __uint_as_float(b); }
    else return __int_as_float(__builtin_amdgcn_ds_swizzle(__float_as_int(v), (O << 10) | 0x1f));
}
__device__ __forceinline__ float xsum64(float v) { v += sxor<1>(v); v += sxor<2>(v); v += sxor<4>(v); v += sxor<8>(v); v += sxor<16>(v); v += sxor<32>(v); return v; }
__device__ __forceinline__ float xmax64(float v) { v = fmaxf(v, sxor<1>(v)); v = fmaxf(v, sxor<2>(v)); v = fmaxf(v, sxor<4>(v)); v = fmaxf(v, sxor<8>(v)); v = fmaxf(v, sxor<16>(v)); v = fmaxf(v, sxor<32>(v)); return v; }
__device__ __forceinline__ float wave_sum(float v) { return xsum64(v); }
__device__ __forceinline__ float sigmoidf_(float x) { return __builtin_amdgcn_rcpf(1.f + __builtin_amdgcn_exp2f(x * -1.4426950408889634f)); }

namespace pg8 {
constexpr int BM = 256, BK = 64, HALF = 128, HTB = HALF * BK * 2, NXCD = 8, WGM = 8;
__host__ __device__ __forceinline__ int lds_byte(int r, int c) { const int st = (r >> 4) * 2 + (c >> 5), rr = r & 15, cc = c & 31, ob = rr * 64 + cc * 2; return st * 1024 + (ob ^ (((ob >> 9) & 1) << 5)); }
__host__ __device__ __forceinline__ void stage_rc(int b, int& R, int& C) { const int st = b / 1024, sb = b % 1024, swz = sb ^ (((sb >> 9) & 1) << 5); R = (st >> 1) * 16 + swz / 64; C = (st & 1) * 32 + (swz % 64) / 2; }
__host__ __device__ __forceinline__ int perm32(int rho) { const int n = rho >> 4, i = rho & 15; return 8 * (i >> 2) + 4 * n + (i & 3); }
struct Unit { int pm, pn; };
struct Gemm { const bf16_t* A; const bf16_t* Bt; int K; };
__device__ __forceinline__ void swz_unit(int L, int nM, int nN, Unit& u) {
    int wgid = L; const int nwg = nM * nN; { const int q = nwg / NXCD, r = nwg % NXCD, xcd = wgid % NXCD, off = wgid / NXCD; wgid = (xcd < r ? xcd * (q + 1) : r * (q + 1) + (xcd - r) * q) + off; }
    const int nig = WGM * nN, gid = wgid / nig, fm = gid * WGM, gsz = (nM - fm) < WGM ? (nM - fm) : WGM;
    u.pm = fm + ((wgid % nig) % gsz); u.pn = (wgid % nig) / gsz;
}
__device__ __forceinline__ unsigned cvt_pk_bf16(float lo, float hi) { unsigned r; asm volatile("v_cvt_pk_bf16_f32 %0, %1, %2" : "=v"(r) : "v"(lo), "v"(hi)); return r; }
__device__ __forceinline__ f32x2 gelu_pk(f32x2 x) {
    const f32x2 u0 = x * 0.70710678f; f32x2 u; u.x = __builtin_amdgcn_fmed3f(u0.x, -3.2f, 3.2f); u.y = __builtin_amdgcn_fmed3f(u0.y, -3.2f, 3.2f);
    const f32x2 t = (u * u) * 0.1953125f - 1.0f;
    f32x2 p = t * 2.982273671e-03f + (-7.046153472e-03f);
    p = p * t + 7.957076705e-03f; p = p * t + (-1.521942819e-02f); p = p * t + 3.318292224e-02f; p = p * t + (-5.471928813e-02f); p = p * t + 8.062700147e-02f;
    p = p * t + (-1.136467381e-01f); p = p * t + 1.543549678e-01f; p = p * t + (-2.173077339e-01f); p = p * t + 4.413341836e-01f;
    const f32x2 e = u * p, hx = x * 0.5f;
    return hx + hx * e;
}

template <class Epi, class Sched>
__device__ __forceinline__ void gemm_phase(LAS unsigned char* lds, const int K, const Sched& S, const Epi& E, const int wv) {
    const int tid = tid_from(wv);
    const int wid = wv, lane = tid & 63, wr = wid >> 2, wc = wid & 3, fr = lane & 15, fq = lane >> 4;
    const int nt = K / BK;
    unsigned voffA[2], voffB[2];
#pragma unroll
    for (int i = 0; i < 2; ++i) { int R, C; stage_rc(tid * 16 + i * 8192, R, C); const int Rb = (R & ~31) + perm32(R & 31);
        voffA[i] = (unsigned)(R * K + C) * 2u; voffB[i] = (unsigned)(Rb * K + C) * 2u; }
    const size_t kstep = (size_t)(BK * 2);
    const size_t hstep = (size_t)HALF * K * 2;
    const unsigned ldsw = (unsigned)wid * 1024u;
    const int aoff = lds_byte(wr * 64 + fr, fq * 8), boff = lds_byte(wc * 32 + fr, fq * 8);
#define PG8_SA(b, h) (((b) * 2 + (h)) * HTB)
#define PG8_SB(b, h) ((4 + (b) * 2 + (h)) * HTB)
#define PG8_STAGE(bufoff, gbase, voff) do { _Pragma("unroll") for (int _i = 0; _i < 2; ++_i) \
        __builtin_amdgcn_global_load_lds((const unsigned*)((const char*)(gbase) + (voff)[_i]), (LAS unsigned*)(lds + (bufoff) + ldsw + _i * 8192), 16, 0, 0); } while (0)
#define PG8_LDA(dst, b, h) do { _Pragma("unroll") for (int m = 0; m < 4; ++m) _Pragma("unroll") for (int k = 0; k < 2; ++k) dst[m][k] = *(const LAS bf16x8*)(lds + PG8_SA(b, h) + aoff + m * 2048 + k * 1024); } while (0)
#define PG8_LDB(dst, b, h) do { _Pragma("unroll") for (int n = 0; n < 2; ++n) _Pragma("unroll") for (int k = 0; k < 2; ++k) dst[n][k] = *(const LAS bf16x8*)(lds + PG8_SB(b, h) + boff + n * 2048 + k * 1024); } while (0)
#define PG8_MMA(ai, bj, At, Bt) do { __builtin_amdgcn_s_setprio(1); _Pragma("unroll") for (int m = 0; m < 4; ++m) _Pragma("unroll") for (int n = 0; n < 2; ++n) _Pragma("unroll") for (int k = 0; k < 2; ++k) \
        acc[ai][bj][m][n] = __builtin_amdgcn_mfma_f32_16x16x32_bf16(Bt[n][k], At[m][k], acc[ai][bj][m][n], 0, 0, 0); __builtin_amdgcn_s_setprio(0); } while (0)
#define PG8_WAIT_V(n) asm volatile("s_waitcnt vmcnt(" #n ")" ::: "memory")
#define PG8_WAIT_L(n) asm volatile("s_waitcnt lgkmcnt(" #n ")" ::: "memory")
#define PG8_BAR __builtin_amdgcn_s_barrier()
#define PG8_SCHED __builtin_amdgcn_sched_barrier(0)
    Unit cur, nxt; int ui = 0;
    if (!S.next(0, cur)) return;
    cur.pm = __builtin_amdgcn_readfirstlane(cur.pm); cur.pn = __builtin_amdgcn_readfirstlane(cur.pn);
    f32x4 acc[2][2][4][2];
#pragma unroll
    for (int a = 0; a < 2; ++a)
#pragma unroll
        for (int b = 0; b < 2; ++b)
#pragma unroll
            for (int m = 0; m < 4; ++m)
#pragma unroll
                for (int n = 0; n < 2; ++n) acc[a][b][m][n] = (f32x4){0.f, 0.f, 0.f, 0.f};
    bf16x8 At[4][2], B0[2][2], B1[2][2];
    const char* cA = S.aptr(cur); const char* cB = S.bptr(cur);
    PG8_STAGE(PG8_SB(0, 0), cB, voffB); PG8_STAGE(PG8_SB(0, 1), cB + hstep, voffB); PG8_STAGE(PG8_SA(0, 0), cA, voffA); PG8_STAGE(PG8_SA(0, 1), cA + hstep, voffA);
    if (wr == 1) PG8_BAR;
    PG8_WAIT_V(2); PG8_BAR;
    PG8_STAGE(PG8_SB(1, 0), cB + kstep, voffB); PG8_STAGE(PG8_SA(1, 0), cA + kstep, voffA); PG8_STAGE(PG8_SB(1, 1), cB + hstep + kstep, voffB);
    PG8_WAIT_V(6); PG8_BAR;
    for (;;) {
        const bool has_next = S.next(ui + 1, nxt);
        nxt.pm = __builtin_amdgcn_readfirstlane(nxt.pm); nxt.pn = __builtin_amdgcn_readfirstlane(nxt.pn);
        const char* nA = has_next ? S.aptr(nxt) : cA; const char* nB = has_next ? S.bptr(nxt) : cB;
        for (int t = 0; t < nt; t += 2) {
            const bool last = (t == nt - 2);
            const char* a1 = cA + (size_t)(t + 1) * kstep;
            const char* a2 = last ? nA : cA + (size_t)(t + 2) * kstep; const char* b2 = last ? nB : cB + (size_t)(t + 2) * kstep;
            const char* a3 = a2 + kstep; const char* b3 = b2 + kstep;
            PG8_LDB(B0, 0, 0); PG8_LDB(B1, 0, 1); PG8_SCHED; PG8_LDA(At, 0, 0); PG8_STAGE(PG8_SA(1, 1), a1 + hstep, voffA);
            PG8_WAIT_V(8); PG8_WAIT_L(0); PG8_BAR; PG8_MMA(0, 0, At, B0); PG8_MMA(0, 1, At, B1); PG8_BAR; PG8_SCHED;
            PG8_LDA(At, 0, 1); PG8_STAGE(PG8_SB(0, 0), b2, voffB); PG8_STAGE(PG8_SB(0, 1), b2 + hstep, voffB); PG8_STAGE(PG8_SA(0, 0), a2, voffA);
            PG8_WAIT_V(8); PG8_WAIT_L(0); PG8_BAR; PG8_MMA(1, 0, At, B0); PG8_MMA(1, 1, At, B1); PG8_BAR; PG8_SCHED;
            PG8_LDB(B0, 1, 0); PG8_LDB(B1, 1, 1); PG8_SCHED; PG8_LDA(At, 1, 0); PG8_STAGE(PG8_SA(0, 1), a2 + hstep, voffA);
            PG8_WAIT_V(8); PG8_WAIT_L(0); PG8_BAR; PG8_MMA(0, 0, At, B0); PG8_MMA(0, 1, At, B1); PG8_BAR; PG8_SCHED;
            PG8_LDA(At, 1, 1); PG8_STAGE(PG8_SB(1, 0), b3, voffB); PG8_STAGE(PG8_SB(1, 1), b3 + hstep, voffB); PG8_STAGE(PG8_SA(1, 0), a3, voffA);
            PG8_WAIT_V(8); PG8_WAIT_L(0); PG8_BAR; PG8_MMA(1, 0, At, B0); PG8_MMA(1, 1, At, B1); PG8_BAR; PG8_SCHED;
        }
        if (wr == 0) PG8_BAR;
        E(acc, cur, wr, wc, fr, fq);
        if (!has_next) break;
#pragma unroll
        for (int a = 0; a < 2; ++a)
#pragma unroll
            for (int b = 0; b < 2; ++b)
#pragma unroll
                for (int m = 0; m < 4; ++m)
#pragma unroll
                    for (int n = 0; n < 2; ++n) acc[a][b][m][n] = (f32x4){0.f, 0.f, 0.f, 0.f};
        cur = nxt; cA = nA; cB = nB; ++ui;
        if (wr == 1) PG8_BAR;
    }
    PG8_WAIT_V(0);
    PG8_BAR;
#undef PG8_SA
#undef PG8_SB
#undef PG8_STAGE
#undef PG8_LDA
#undef PG8_LDB
#undef PG8_MMA
#undef PG8_WAIT_V
#undef PG8_WAIT_L
#undef PG8_BAR
#undef PG8_SCHED
}
}
using pg8::Unit;
typedef f32x4 (&AccRef)[2][2][4][2];

struct SchedIn {
    int G, c; const char* H; const char* W;
    __device__ __forceinline__ bool next(int i, Unit& u) const {
        int L = i * G + c;
        if (L < 6656) { pg8::swz_unit(L, 256, 26, u); u.pn = u.pn < 12 ? u.pn : u.pn + 2; return true; }
        L -= 6656;
        if (L < 512) { u.pm = 1024 + (L & 1); u.pn = L >> 1; return true; }
        L -= 512;
        if (L < 64) { u.pm = 2048 + (L >> 1); u.pn = 28 + (L & 1); return true; }
        L -= 64;
        if (L < 64) { u.pm = 3072 + (L & 1); u.pn = L >> 1; return true; }
        return false;
    }
    __device__ __forceinline__ const char* aptr(const Unit& u) const { const int ty = u.pm >> 10, idx = u.pm & 1023;
        const long row = ty == 0 ? (long)idx * 256 : (ty == 1 ? (long)(12 + idx) * 256 : (ty == 2 ? (long)MTOK + idx * 256 : (long)(30 + idx) * 256));
        return ((ty & 1) ? W : H) + row * 2048; }
    __device__ __forceinline__ const char* bptr(const Unit& u) const { const int ty = u.pm >> 10;
        const long row = ty == 3 ? (long)MTOK + u.pn * 256 : (long)u.pn * 256;
        return ((ty & 1) ? H : W) + row * 2048; }
};
struct SchedMerge {
    int p; const char* A; const char* B;
    __device__ __forceinline__ bool next(int i, Unit& u) const {
        if (i >= 12) return false; const int pn = i / 3, j = i - 3 * pn; u.pm = j * 256 + p; u.pn = j * 4 + pn; return true;
    }
    __device__ __forceinline__ const char* aptr(const Unit& u) const { return A + (long)u.pm * 256 * 1024; }
    __device__ __forceinline__ const char* bptr(const Unit& u) const { return B + (long)u.pn * 256 * 1024; }
};
struct SchedPanel {
    int p; const char* A; const char* B; long rowb;
    __device__ __forceinline__ bool next(int i, Unit& u) const { if (i >= 4) return false; u.pm = p; u.pn = i; return true; }
    __device__ __forceinline__ const char* aptr(const Unit& u) const { return A + (long)u.pm * 256 * rowb; }
    __device__ __forceinline__ const char* bptr(const Unit& u) const { return B + (long)u.pn * 256 * rowb; }
};
struct SchedPlain {
    int G, c, nM, nN, rstride, roff; const char* A; const char* B; long rowb;
    __device__ __forceinline__ bool next(int i, Unit& u) const {
        const int L = i * G + c; if (L >= nM * nN) return false;
        pg8::swz_unit(L, nM, nN, u); return true;
    }
    __device__ __forceinline__ const char* aptr(const Unit& u) const { return A + ((long)u.pm * rstride + roff) * rowb; }
    __device__ __forceinline__ const char* bptr(const Unit& u) const { return B + (long)u.pn * 256 * rowb; }
};

struct EpiIn {
    bf16_t* z; bf16_t* gates; bf16_t* memk; bf16_t* memvt; const float* lbl; const float* gtab; LAS float* hs;
    __device__ __forceinline__ void operator()(AccRef acc, const Unit& u, int wr, int wc, int fr, int fq) const {
        const int ty = u.pm >> 10, idx = u.pm & 1023, pn = u.pn;
        bf16_t* base; size_t ldc; int mode = 0; int c0; int rbase;
        if (ty == 1) {
            const int tk = pn * 256 + wc * 32 + 8 * fq; const int b = tk >> 11;
            base = z + 6 * ((size_t)MTOK * 512) + (size_t)b * 512 * 2048; ldc = 2048; c0 = tk & 2047; rbase = idx * 256 + wr * 64 + fr;
        } else if (ty == 3) {
            const int mi = pn * 256 + wc * 32 + 8 * fq; const int b = mi >> 8;
            base = memvt + (size_t)b * 512 * 256; ldc = 256; c0 = mi & 255; rbase = idx * 256 + wr * 64 + fr;
        } else if (ty == 2) {
            base = memk; ldc = 512; c0 = (pn - 28) * 256 + wc * 32 + 8 * fq; rbase = idx * 256 + wr * 64 + fr; mode = 5;
        } else if (pn >= 16) {
            base = gates; ldc = 3072; c0 = (pn - 16) * 256 + wc * 32 + 8 * fq; rbase = idx * 256 + wr * 64 + fr; mode = 3;
        } else { const int reg = pn >> 1;
            base = z + (size_t)reg * ((size_t)MTOK * 512); ldc = 512; c0 = (pn & 1) * 256 + wc * 32 + 8 * fq; rbase = idx * 256 + wr * 64 + fr;
            mode = (reg == 0 || reg == 3) ? 1 : (reg == 1 ? 2 : ((reg == 4 || reg == 5) ? 4 : (reg == 7 ? 5 : 0)));
        }
        if (mode >= 4) {
            const int rloc = wr * 64 + fr; const bool wide = (mode == 5); const bool isq = wide ? (ty == 0) : (pn < 10);
#pragma unroll
            for (int ai = 0; ai < 2; ++ai)
#pragma unroll
                for (int m = 0; m < 4; ++m)
#pragma unroll
                    for (int bj = 0; bj < 2; ++bj) { const f32x4 a0 = acc[ai][bj][m][0], a1 = acc[ai][bj][m][1];
                        float sq = (a0[0] * a0[0] + a0[1] * a0[1]) + (a0[2] * a0[2] + a0[3] * a0[3]) + (a1[0] * a1[0] + a1[1] * a1[1]) + (a1[2] * a1[2] + a1[3] * a1[3]);
                        sq += sxor<16>(sq); sq += sxor<32>(sq);
                        if (fq == 0) hs[((rloc + ai * 128 + m * 16) * 2 + bj) * 4 + wc] = sq; }
            asm volatile("s_waitcnt lgkmcnt(0)" ::: "memory");
            __builtin_amdgcn_s_barrier();
            const float* gp = gtab + (wide ? (isq ? 128 : 256) + wc * 32 : (isq ? 0 : 64) + (wc & 1) * 32) + 8 * fq;
            const float gsc = isq ? (wide ? 0.08838834764831845f : 0.125f) * 1.4426950408889634f : 1.f;
            float gg[8];
#pragma unroll
            for (int i = 0; i < 8; ++i) gg[i] = gp[i] * gsc;
#pragma unroll
            for (int ai = 0; ai < 2; ++ai)
#pragma unroll
                for (int m = 0; m < 4; ++m)
#pragma unroll
                    for (int bj = 0; bj < 2; ++bj) { const LAS float* hp = hs + ((rloc + ai * 128 + m * 16) * 2 + bj) * 4; const f32x4 h4 = *(const LAS f32x4*)hp;
                        const float rs = wide ? __builtin_amdgcn_rsqf(((h4[0] + h4[1]) + (h4[2] + h4[3])) * (1.f / 128.f) + EPS) : __builtin_amdgcn_rsqf(((wc & 2) ? (h4[2] + h4[3]) : (h4[0] + h4[1])) * (1.f / 64.f) + EPS);
                        const f32x4 a0 = acc[ai][bj][m][0], a1 = acc[ai][bj][m][1];
                        u32x4 w; w.x = pk2(a0[0] * rs * gg[0], a0[1] * rs * gg[1]); w.y = pk2(a0[2] * rs * gg[2], a0[3] * rs * gg[3]); w.z = pk2(a1[0] * rs * gg[4], a1[1] * rs * gg[5]); w.w = pk2(a1[2] * rs * gg[6], a1[3] * rs * gg[7]);
                        *(u32x4*)(base + (size_t)(rbase + ai * 128 + m * 16) * ldc + c0 + bj * 128) = w; }
            return;
        }
#pragma unroll
        for (int bj = 0; bj < 2; ++bj) {
            float lb[8];
            if (mode == 2) {
#pragma unroll
                for (int i = 0; i < 8; ++i) { const float l0 = lbl[c0 + bj * 128 + i], l1 = lbl[512 + c0 + bj * 128 + i]; lb[i] = __builtin_amdgcn_rcpf(1.f + __expf(l1 - l0)); }
            }
#pragma unroll
            for (int ai = 0; ai < 2; ++ai)
#pragma unroll
                for (int m = 0; m < 4; ++m) { float v[8];
#pragma unroll
                    for (int i = 0; i < 8; ++i) v[i] = acc[ai][bj][m][i >> 2][i & 3];
                    if (mode == 1) {
#pragma unroll
                        for (int i = 0; i < 8; ++i) v[i] = v[i] * sigmoidf_(v[i]);
                    } else if (mode == 2) {
#pragma unroll
                        for (int i = 0; i < 8; ++i) v[i] = __logf(lb[i] + (1.f - lb[i]) * sigmoidf_(v[i]));
                    } else if (mode == 3) {
#pragma unroll
                        for (int i = 0; i < 8; ++i) v[i] = sigmoidf_(v[i]);
                    }
                    u32x4 w; w.x = pk2(v[0], v[1]); w.y = pk2(v[2], v[3]); w.z = pk2(v[4], v[5]); w.w = pk2(v[6], v[7]);
                    *(u32x4*)(base + (size_t)(rbase + ai * 128 + m * 16) * ldc + c0 + bj * 128) = w; }
        }
    }
};

struct EpiMerge {
    const bf16_t* gates; bf16_t* part; bf16_t* merged;
    __device__ __forceinline__ void operator()(AccRef acc, const Unit& u, int wr, int wc, int fr, int fq) const {
        const int j = u.pm >> 8, pm = u.pm & 255, pn = u.pn & 3;
        const int rbase = pm * 256 + wr * 64 + fr, c0 = pn * 256 + wc * 32 + 8 * fq;
#pragma unroll
        for (int ai = 0; ai < 2; ++ai)
#pragma unroll
            for (int m = 0; m < 4; ++m) { const size_t r = (size_t)(rbase + ai * 128 + m * 16);
#pragma unroll
                for (int bj = 0; bj < 2; ++bj) { const int c = c0 + bj * 128;
                    const u32x4 gw = *(const u32x4*)(gates + r * 3072 + j * 1024 + c);
                    f32x4 v0 = acc[ai][bj][m][0], v1 = acc[ai][bj][m][1];
                    v0[0] *= bflo(gw.x); v0[1] *= bfhi(gw.x); v0[2] *= bflo(gw.y); v0[3] *= bfhi(gw.y);
                    v1[0] *= bflo(gw.z); v1[1] *= bfhi(gw.z); v1[2] *= bflo(gw.w); v1[3] *= bfhi(gw.w);
                    if (j == 2) { const u32x4 p0 = *(const u32x4*)(part + r * 1024 + c), p1 = *(const u32x4*)(part + (size_t)MTOK * 1024 + r * 1024 + c);
                        v0[0] += bflo(p0.x) + bflo(p1.x); v0[1] += bfhi(p0.x) + bfhi(p1.x); v0[2] += bflo(p0.y) + bflo(p1.y); v0[3] += bfhi(p0.y) + bfhi(p1.y);
                        v1[0] += bflo(p0.z) + bflo(p1.z); v1[1] += bfhi(p0.z) + bfhi(p1.z); v1[2] += bflo(p0.w) + bflo(p1.w); v1[3] += bfhi(p0.w) + bfhi(p1.w); }
                    u32x4 w; w.x = pk2(v0[0], v0[1]); w.y = pk2(v0[2], v0[3]); w.z = pk2(v1[0], v1[1]); w.w = pk2(v1[2], v1[3]);
                    bf16_t* dst = (j == 2) ? merged : part + (size_t)j * MTOK * 1024;
                    *(u32x4*)(dst + r * 1024 + c) = w; } }
    }
};

struct EpiOut {
    const float* x; bf16_t* x1b; float* rstd; LAS float* rowss; int wv;
    __device__ __forceinline__ void operator()(AccRef acc, const Unit& u, int wr, int wc, int fr, int fq) const {
        const int rloc = wr * 64 + fr, rbase = u.pm * 256 + rloc, c0 = u.pn * 256 + wc * 32 + 8 * fq;
#pragma unroll
        for (int ai = 0; ai < 2; ++ai)
#pragma unroll
            for (int m = 0; m < 4; ++m) { const size_t r = (size_t)(rbase + ai * 128 + m * 16); float sq = 0.f;
#pragma unroll
                for (int bj = 0; bj < 2; ++bj) { const int c = c0 + bj * 128;
                    f32x4 v0 = acc[ai][bj][m][0] + *(const f32x4*)(x + r * 1024 + c), v1 = acc[ai][bj][m][1] + *(const f32x4*)(x + r * 1024 + c + 4);
                    sq += v0[0] * v0[0] + v0[1] * v0[1] + v0[2] * v0[2] + v0[3] * v0[3] + v1[0] * v1[0] + v1[1] * v1[1] + v1[2] * v1[2] + v1[3] * v1[3];
                    u32x4 w; w.x = pk2(v0[0], v0[1]); w.y = pk2(v0[2], v0[3]); w.z = pk2(v1[0], v1[1]); w.w = pk2(v1[2], v1[3]); *(u32x4*)(x1b + r * 1024 + c) = w; }
                sq += sxor<16>(sq); sq += sxor<32>(sq);
                if (fq == 0) { LAS float* sl = rowss + (rloc + ai * 128 + m * 16) * 4 + wc; *sl = (u.pn == 0) ? sq : (*sl + sq); } }
        if (u.pn == 3) {
            asm volatile("s_waitcnt lgkmcnt(0)" ::: "memory");
            __builtin_amdgcn_s_barrier();
            const int t = tid_from(wv);
            if (t < 256) { const f32x4 q = *(const LAS f32x4*)(rowss + t * 4); rstd[u.pm * 256 + t] = __builtin_amdgcn_rsqf(((q[0] + q[1]) + (q[2] + q[3])) * (1.f / 1024.f) + EPS); }
            asm volatile("s_waitcnt lgkmcnt(0)" ::: "memory");
            __builtin_amdgcn_s_barrier();
        }
    }
};

template <int CTRL> __device__ __forceinline__ float dppf(float v) {
    return __builtin_bit_cast(float, __builtin_amdgcn_update_dpp(0, __builtin_bit_cast(int, v), CTRL, 0xf, 0xf, true));
}
struct EpiUp {
    const float* ss; const float* cw; const float* cb; bf16_t* y; LAS float* hal;
    __device__ __forceinline__ void operator()(AccRef acc, const Unit& u, int wr, int wc, int fr, int fq) const {
        const int R0 = 254 * u.pm - 2 + wr * 64 + fr;
        const int chl = wc * 32 + 8 * fq;
        const int gch = u.pn * 128 + chl;
#pragma unroll
        for (int ai = 0; ai < 2; ++ai)
#pragma unroll
            for (int m = 0; m < 4; ++m) { const int R = R0 + ai * 128 + m * 16; float rs = 0.f;
                if (R >= 0 && R < MTOK) rs = ss[R];
#pragma unroll
                for (int bj = 0; bj < 2; ++bj)
#pragma unroll
                    for (int n = 0; n < 2; ++n) acc[ai][bj][m][n] = acc[ai][bj][m][n] * rs; }
        if (fr >= 14) {
#pragma unroll
            for (int ai = 0; ai < 2; ++ai) { LAS float* hp = hal + ((2 * ai + wr) * 2 + (fr - 14)) * 128 + chl;
                *(LAS f32x4*)hp = acc[ai][0][3][0]; *(LAS f32x4*)(hp + 4) = acc[ai][0][3][1]; }
        }
        asm volatile("s_waitcnt lgkmcnt(0)" ::: "memory");
        __builtin_amdgcn_s_barrier();
        f32x4 w0[2], w1[2], w2[2], bb[2];
#pragma unroll
        for (int n = 0; n < 2; ++n) { w0[n] = *(const f32x4*)(cw + gch + 4 * n); w1[n] = *(const f32x4*)(cw + FFD + gch + 4 * n); w2[n] = *(const f32x4*)(cw + 2 * FFD + gch + 4 * n); bb[n] = *(const f32x4*)(cb + gch + 4 * n); }
#pragma unroll
        for (int ai = 0; ai < 2; ++ai) { const int blk = 2 * ai + wr;
            f32x4 H[2]; H[0] = (f32x4){0.f, 0.f, 0.f, 0.f}; H[1] = H[0];
            if (fr >= 14 && blk >= 1) { const LAS float* hp = hal + ((blk - 1) * 2 + (fr - 14)) * 128 + chl; H[0] = *(const LAS f32x4*)hp; H[1] = *(const LAS f32x4*)(hp + 4); }
#pragma unroll
            for (int m = 3; m >= 0; --m) { const int tr = ai * 128 + wr * 64 + m * 16 + fr; const int R = R0 + ai * 128 + m * 16; const int tt = R & 2047;
                float o[8];
#pragma unroll
                for (int n = 0; n < 2; ++n)
#pragma unroll
                    for (int e = 0; e < 4; ++e) { const float xc = acc[ai][0][m][n][e]; const float xp = (m == 0) ? H[n][e] : acc[ai][0][m > 0 ? m - 1 : 0][n][e];
                        float p1 = __builtin_bit_cast(float, __builtin_amdgcn_update_dpp(__builtin_bit_cast(int, dppf<0x121>(xp)), __builtin_bit_cast(int, xc), 0x111, 0xf, 0xf, false));
                        float p2 = __builtin_bit_cast(float, __builtin_amdgcn_update_dpp(__builtin_bit_cast(int, dppf<0x122>(xp)), __builtin_bit_cast(int, xc), 0x112, 0xf, 0xf, false));
                        if (tt < 1) p1 = 0.f;
                        if (tt < 2) p2 = 0.f;
                        o[4 * n + e] = w2[n][e] * xc + w1[n][e] * p1 + w0[n][e] * p2 + bb[n][e]; }
                if (tr >= 2 && R < MTOK) {
                    const f32x2 g0 = pg8::gelu_pk((f32x2){o[0], o[1]}), g1 = pg8::gelu_pk((f32x2){o[2], o[3]}), g2 = pg8::gelu_pk((f32x2){o[4], o[5]}), g3 = pg8::gelu_pk((f32x2){o[6], o[7]});
                    const f32x4 v0 = acc[ai][1][m][0], v1 = acc[ai][1][m][1];
                    u32x4 w; w.x = pk2(g0.x * v0[0], g0.y * v0[1]); w.y = pk2(g1.x * v0[2], g1.y * v0[3]); w.z = pk2(g2.x * v1[0], g2.y * v1[1]); w.w = pk2(g3.x * v1[2], g3.y * v1[3]);
                    *(u32x4*)(y + (size_t)R * FFD + gch) = w; } } }
    }
};

struct EpiDown {
    const bf16_t* x1b; float* out;
    __device__ __forceinline__ void operator()(AccRef acc, const Unit& u, int wr, int wc, int fr, int fq) const {
        const int rbase = u.pm * 256 + wr * 64 + fr, c0 = u.pn * 256 + wc * 32 + 8 * fq;
#pragma unroll
        for (int ai = 0; ai < 2; ++ai)
#pragma unroll
            for (int m = 0; m < 4; ++m) { const size_t r = (size_t)(rbase + ai * 128 + m * 16);
#pragma unroll
                for (int bj = 0; bj < 2; ++bj) { const size_t o = r * 1024 + c0 + bj * 128; const u32x4 xw = *(const u32x4*)(x1b + o);
                    f32x4 v0 = acc[ai][bj][m][0], v1 = acc[ai][bj][m][1];
                    v0[0] += bflo(xw.x); v0[1] += bfhi(xw.x); v0[2] += bflo(xw.y); v0[3] += bfhi(xw.y); v1[0] += bflo(xw.z); v1[1] += bfhi(xw.z); v1[2] += bflo(xw.w); v1[3] += bfhi(xw.w);
                    *(f32x4*)(out + o) = v0; *(f32x4*)(out + o + 4) = v1; } }
    }
};

__device__ __forceinline__ void transpose_item(const float* W, int ldw, int K, bf16_t* WT, int n0, int sc0, int k0, const float* ksc, LAS float* scr, int lane) {
#pragma unroll
    for (int i = 0; i < 32; ++i) { const int kk = 2 * i + (lane >> 5); float w = W[(size_t)(k0 + kk) * ldw + sc0 + (lane & 31)]; if (ksc) w *= ksc[k0 + kk]; scr[kk * 33 + (lane & 31)] = w; }
    asm volatile("s_waitcnt lgkmcnt(0)" ::: "memory");
    const int c = lane & 7;
#pragma unroll
    for (int j = 0; j < 4; ++j) { const int n = (lane >> 3) + 8 * j; const LAS float* s = scr + (8 * c) * 33 + n;
        u32x4 o; o.x = pk2(s[0 * 33], s[1 * 33]); o.y = pk2(s[2 * 33], s[3 * 33]); o.z = pk2(s[4 * 33], s[5 * 33]); o.w = pk2(s[6 * 33], s[7 * 33]);
        *(u32x4*)(WT + (size_t)(n0 + n) * K + k0 + 8 * c) = o; }
    asm volatile("s_waitcnt lgkmcnt(0)" ::: "memory");
}

struct Params {
    const float* in[22]; float* out; unsigned char* ws;
};

template <bool FF> __device__ __forceinline__ void norm_rows(const float* xbase, int nrows, int gw, int NGW, const float* g, bf16_t* obase, const LAS float* ffw, const float* fbias, float* flog, int lane) {
    f32x4 gr[4];
#pragma unroll
    for (int j = 0; j < 4; ++j) gr[j] = ((const f32x4*)g)[lane + 64 * j];
    f32x4 nv[2][4];
#pragma unroll
    for (int r = 0; r < 2; ++r) { const int m = gw + r * NGW; const int mc = m < nrows ? m : nrows - 1;
#pragma unroll
        for (int j = 0; j < 4; ++j) nv[r][j] = ((const f32x4*)(xbase + (size_t)mc * DM))[lane + 64 * j]; }
    for (int m0 = gw; m0 < nrows; m0 += 2 * NGW) {
        f32x4 v[2][4]; float s[2];
#pragma unroll
        for (int r = 0; r < 2; ++r) { s[r] = 0.f;
#pragma unroll
            for (int j = 0; j < 4; ++j) { v[r][j] = nv[r][j]; s[r] += (v[r][j][0] * v[r][j][0] + v[r][j][1] * v[r][j][1]) + (v[r][j][2] * v[r][j][2] + v[r][j][3] * v[r][j][3]); } }
#pragma unroll
        for (int r = 0; r < 2; ++r) { const int m = m0 + (2 + r) * NGW; const int mc = m < nrows ? m : nrows - 1;
#pragma unroll
            for (int j = 0; j < 4; ++j) nv[r][j] = ((const f32x4*)(xbase + (size_t)mc * DM))[lane + 64 * j]; }
        s[0] = xsum64(s[0]); s[1] = xsum64(s[1]);
        float dd[2][8];
#pragma unroll
        for (int r = 0; r < 2; ++r) { const int m = m0 + r * NGW; const bool ok = m < nrows;
            const float rstd = __builtin_amdgcn_rsqf(s[r] * (1.f / DM) + EPS);
#pragma unroll
            for (int j = 0; j < 4; ++j) v[r][j] = v[r][j] * rstd * gr[j];
            if (ok) { u32x2* o8 = (u32x2*)(obase + (size_t)m * DM) + lane;
#pragma unroll
                for (int j = 0; j < 4; ++j) { u32x2 w; w.x = pk2(v[r][j][0], v[r][j][1]); w.y = pk2(v[r][j][2], v[r][j][3]); o8[64 * j] = w; } } }
        if (FF) {
#pragma unroll
            for (int jj = 0; jj < 8; ++jj) { float t0 = 0.f, t1 = 0.f;
#pragma unroll
                for (int j = 0; j < 4; ++j) { const f32x4 w = *(const LAS f32x4*)(ffw + jj * 1024 + 4 * (lane + 64 * j));
                    t0 += v[0][j][0] * w[0] + v[0][j][1] * w[1] + v[0][j][2] * w[2] + v[0][j][3] * w[3]; t1 += v[1][j][0] * w[0] + v[1][j][1] * w[1] + v[1][j][2] * w[2] + v[1][j][3] * w[3]; }
                dd[0][jj] = t0; dd[1][jj] = t1; }
            const bool b5 = (lane & 32) != 0, b4 = (lane & 16) != 0, b3 = (lane & 8) != 0;
            float rr[2];
#pragma unroll
            for (int r = 0; r < 2; ++r) { float k4[4], k2[2];
#pragma unroll
                for (int j = 0; j < 4; ++j) { const float snd = b5 ? dd[r][j] : dd[r][j + 4], kp = b5 ? dd[r][j + 4] : dd[r][j]; k4[j] = kp + sxor<32>(snd); }
#pragma unroll
                for (int j = 0; j < 2; ++j) { const float snd = b4 ? k4[j] : k4[j + 2], kp = b4 ? k4[j + 2] : k4[j]; k2[j] = kp + sxor<16>(snd); }
                { const float snd = b3 ? k2[0] : k2[1], kp = b3 ? k2[1] : k2[0]; rr[r] = kp + sxor<8>(snd); }
                rr[r] += sxor<4>(rr[r]); rr[r] += sxor<2>(rr[r]); rr[r] += sxor<1>(rr[r]); }
            if ((lane & 7) == 0) { const int jj = lane >> 3;
#pragma unroll
                for (int r = 0; r < 2; ++r) { const int m = m0 + r * NGW; if (m < nrows) { const float zz = rr[r] + fbias[jj]; flog[(size_t)m * 8 + jj] = fminf(zz, 0.f) - log1pf(__expf(-fabsf(zz))); } } }
        }
    }
}

typedef float f32x16 __attribute__((ext_vector_type(16)));
__device__ __forceinline__ float swapmax(float v) { auto rr = __builtin_amdgcn_permlane32_swap(__float_as_uint(v), __float_as_uint(v), false, false); const unsigned a = rr[0], b = rr[1]; return fmaxf(__uint_as_float(a), __uint_as_float(b)); }
__device__ __forceinline__ float swapsum(float v) { auto rr = __builtin_amdgcn_permlane32_swap(__float_as_uint(v), __float_as_uint(v), false, false); const unsigned a = rr[0], b = rr[1]; return __uint_as_float(a) + __uint_as_float(b); }
template <int D, bool FOX, int KS, int VS>
__device__ __forceinline__ void attn_tile(const LAS bf16_t* Ks, const LAS bf16_t* Vs, const bf16x8 (&qf)[D / 16], const bf16x8 qx, f32x16 (&O)[D / 32], float& mrow, float& lrow,
                                          int k0, int q0w, int r32, int hi) {
    f32x16 s[2];
#pragma unroll
    for (int kb = 0; kb < 2; ++kb) {
#pragma unroll
        for (int j = 0; j < 16; ++j) s[kb][j] = 0.f;
#pragma unroll
        for (int ks = 0; ks < D / 16; ++ks) { const bf16x8 kf = *(const LAS bf16x8*)(Ks + (32 * kb + r32) * KS + 16 * ks + 8 * hi);
            s[kb] = __builtin_amdgcn_mfma_f32_32x32x16_bf16(kf, qf[ks], s[kb], 0, 0, 0); }
        if (FOX) {
            const bf16x8 kx = *(const LAS bf16x8*)(Ks + (32 * kb + r32) * KS + D + 8 * hi);
            s[kb] = __builtin_amdgcn_mfma_f32_32x32x16_bf16(kx, qx, s[kb], 0, 0, 0); } }
    if (FOX) {
        if (k0 + 63 > q0w) {
#pragma unroll
            for (int kb = 0; kb < 2; ++kb)
#pragma unroll
                for (int j = 0; j < 16; ++j) { const int key = k0 + 32 * kb + 8 * (j >> 2) + 4 * hi + (j & 3); if (key > q0w + r32) s[kb][j] = -1e30f; }
        }
    }
    float mx = fmaxf(s[0][0], s[1][0]);
#pragma unroll
    for (int j = 1; j < 16; ++j) mx = fmaxf(mx, fmaxf(s[0][j], s[1][j]));
    mx = swapmax(mx);
    if (__builtin_amdgcn_ballot_w64(mx > mrow) != 0ull) {
        const float mn = fmaxf(mrow, mx); const float al = __builtin_amdgcn_exp2f(mrow - mn); mrow = mn;
        lrow = lrow * al;
#pragma unroll
        for (int i = 0; i < D / 32; ++i) O[i] = O[i] * al;
    }
    const float mn = mrow;
    float ps = 0.f;
#pragma unroll
    for (int kb = 0; kb < 2; ++kb)
#pragma unroll
        for (int j = 0; j < 16; ++j) { const float p = __builtin_amdgcn_exp2f(s[kb][j] - mn); s[kb][j] = p; ps += p; }
    lrow += ps;
#pragma unroll
    for (int kb = 0; kb < 2; ++kb)
#pragma unroll
        for (int sx = 0; sx < 2; ++sx) { u32x4 pw; pw.x = pk2(s[kb][8 * sx + 0], s[kb][8 * sx + 1]); pw.y = pk2(s[kb][8 * sx + 2], s[kb][8 * sx + 3]); pw.z = pk2(s[kb][8 * sx + 4], s[kb][8 * sx + 5]); pw.w = pk2(s[kb][8 * sx + 6], s[kb][8 * sx + 7]);
            const bf16x8 pf = __builtin_bit_cast(bf16x8, pw);
#pragma unroll
            for (int db = 0; db < D / 32; ++db) { const LAS bf16_t* vp = Vs + (32 * db + r32) * VS + 32 * kb + 16 * sx + 4 * hi;
                const u32x2 lo = *(const LAS u32x2*)vp, hi2 = *(const LAS u32x2*)(vp + 8); const u32x4 vw = {lo.x, lo.y, hi2.x, hi2.y};
                O[db] = __builtin_amdgcn_mfma_f32_32x32x16_bf16(__builtin_bit_cast(bf16x8, vw), pf, O[db], 0, 0, 0); } }
}
template <int D> __device__ __forceinline__ void q_frags(const u32x4 (&qw)[D / 16], const float* qg, float scale, int hi, bf16x8 (&qf)[D / 16]) {
    float ssq = 0.f;
#pragma unroll
    for (int ks = 0; ks < D / 16; ++ks) { const float t0 = bflo(qw[ks].x), t1 = bfhi(qw[ks].x), t2 = bflo(qw[ks].y), t3 = bfhi(qw[ks].y), t4 = bflo(qw[ks].z), t5 = bfhi(qw[ks].z), t6 = bflo(qw[ks].w), t7 = bfhi(qw[ks].w);
        ssq += (t0 * t0 + t1 * t1) + (t2 * t2 + t3 * t3) + (t4 * t4 + t5 * t5) + (t6 * t6 + t7 * t7); }
    ssq = swapsum(ssq);
    const float rs = scale * __builtin_amdgcn_rsqf(ssq * (1.f / D) + EPS);
#pragma unroll
    for (int ks = 0; ks < D / 16; ++ks) { const f32x4 g0 = *(const f32x4*)(qg + 16 * ks + 8 * hi), g1 = *(const f32x4*)(qg + 16 * ks + 8 * hi + 4); u32x4 w;
        w.x = pk2(bflo(qw[ks].x) * rs * g0[0], bfhi(qw[ks].x) * rs * g0[1]); w.y = pk2(bflo(qw[ks].y) * rs * g0[2], bfhi(qw[ks].y) * rs * g0[3]);
        w.z = pk2(bflo(qw[ks].z) * rs * g1[0], bfhi(qw[ks].z) * rs * g1[1]); w.w = pk2(bflo(qw[ks].w) * rs * g1[2], bfhi(qw[ks].w) * rs * g1[3]); qf[ks] = __builtin_bit_cast(bf16x8, w); }
}
template <int D> __device__ __forceinline__ void o_store(const f32x16 (&O)[D / 32], float lrow, bf16_t* orow, int hi) {
    const float linv = __builtin_amdgcn_rcpf(swapsum(lrow));
#pragma unroll
    for (int db = 0; db < D / 32; ++db)
#pragma unroll
        for (int g4 = 0; g4 < 4; g4 += 2) {
            unsigned ax = pk2(O[db][4 * g4] * linv, O[db][4 * g4 + 1] * linv), ay = pk2(O[db][4 * g4 + 2] * linv, O[db][4 * g4 + 3] * linv);
            unsigned bx = pk2(O[db][4 * g4 + 4] * linv, O[db][4 * g4 + 5] * linv), by = pk2(O[db][4 * g4 + 6] * linv, O[db][4 * g4 + 7] * linv);
            { auto r = __builtin_amdgcn_permlane32_swap(ax, bx, false, false); const unsigned r0 = r[0], r1 = r[1]; ax = r0; bx = r1; }
            { auto r = __builtin_amdgcn_permlane32_swap(ay, by, false, false); const unsigned r0 = r[0], r1 = r[1]; ay = r0; by = r1; }
            *(u32x4*)(orow + 32 * db + 8 * g4 + (hi ? 8 : 0)) = (u32x4){ax, ay, bx, by}; }
}
__device__ __forceinline__ void o_store_lds64(const f32x16 (&O)[2], float lrow, bf16_t* obase  , int ldo, LAS bf16_t* stg, int r32, int hi, int lane) {
    constexpr int SS_ = 72;
    const float linv = __builtin_amdgcn_rcpf(swapsum(lrow));
#pragma unroll
    for (int db = 0; db < 2; ++db)
#pragma unroll
        for (int g4 = 0; g4 < 4; ++g4) { u32x2 w; w.x = pk2(O[db][4 * g4] * linv, O[db][4 * g4 + 1] * linv); w.y = pk2(O[db][4 * g4 + 2] * linv, O[db][4 * g4 + 3] * linv);
            *(LAS u32x2*)(stg + r32 * SS_ + 32 * db + 8 * g4 + 4 * hi) = w; }
    asm volatile("s_waitcnt lgkmcnt(0)" ::: "memory");
#pragma unroll
    for (int i = 0; i < 4; ++i) { const int row = (lane >> 3) + 8 * i, ch = lane & 7; const u32x4 v = *(const LAS u32x4*)(stg + row * SS_ + 8 * ch);
        *(u32x4*)(obase + (size_t)row * ldo + 8 * ch) = v; }
}

template <int D> __device__ __forceinline__ u32x4 knorm_chunk(const u32x4 w, const float (&kgr)[8]) {
    constexpr int NKC = D / 8; float t[8];
    t[0] = bflo(w.x); t[1] = bfhi(w.x); t[2] = bflo(w.y); t[3] = bfhi(w.y); t[4] = bflo(w.z); t[5] = bfhi(w.z); t[6] = bflo(w.w); t[7] = bfhi(w.w);
    float sq = (t[0] * t[0] + t[1] * t[1]) + (t[2] * t[2] + t[3] * t[3]) + (t[4] * t[4] + t[5] * t[5]) + (t[6] * t[6] + t[7] * t[7]);
    sq += sxor<1>(sq); sq += sxor<2>(sq); sq += sxor<4>(sq); if (NKC == 16) sq += sxor<8>(sq);
    const float rs = __builtin_amdgcn_rsqf(sq * (1.f / D) + EPS);
    u32x4 o4; o4.x = pk2(t[0] * rs * kgr[0], t[1] * rs * kgr[1]); o4.y = pk2(t[2] * rs * kgr[2], t[3] * rs * kgr[3]); o4.z = pk2(t[4] * rs * kgr[4], t[5] * rs * kgr[5]); o4.w = pk2(t[6] * rs * kgr[6], t[7] * rs * kgr[7]);
    return o4;
}

__device__ __forceinline__ void fox_unit(LAS unsigned char* lds, const bf16_t* Qp, const bf16_t* Kp, const bf16_t* Vt, const float* qg, const float* kg, const float* Fc, int q0, int nkt, const int* ktab, bf16_t* Op, const int wv) {
    constexpr int D = 64, KS = D + 16 + 8, VS = 72, ldq = 512, ldk = 512, ldvt = 2048, ldo = 512, NB = 5;
    constexpr int BUFB = 64 * KS * 2 + D * VS * 2;
    constexpr float L2E = 1.4426950408889634f;
    const int tid = tid_from(wv);
    const int wid = wv, lane = tid & 63, r32 = lane & 31, hi = lane >> 5;
    const int q0w = q0 + wid * 32, tq = q0 >> 6, dw = tq + (wid >> 1);
    const int kt0 = __builtin_amdgcn_readfirstlane(ktab[q0 >> 5]), ktw = __builtin_amdgcn_readfirstlane(ktab[q0w >> 5]);
    int nsteps = 0;
#pragma unroll
    for (int w = 0; w < 8; ++w) { const int n = tq + (w >> 1) - __builtin_amdgcn_readfirstlane(ktab[(q0 >> 5) + w]) + 1; nsteps = n > nsteps ? n : nsteps; }
    bf16x8 qf[4];
    { const bf16_t* qrow = Qp + (size_t)(q0w + r32) * ldq + 8 * hi;
#pragma unroll
      for (int ks = 0; ks < 4; ++ks) qf[ks] = *(const bf16x8*)(qrow + 16 * ks); }
    bf16x8 qx;
    { const float F = Fc[q0w + r32] * L2E; const unsigned c1 = f2bf(F); const float r1 = F - bf1((bf16_t)c1); const unsigned c2 = f2bf(r1); const float r2 = r1 - bf1((bf16_t)c2); const unsigned c3 = f2bf(r2);
      u32x4 w = {c1 | (c2 << 16), c3 | (0x3f80u << 16), 0x3f80u | (0x3f80u << 16), 0u}; if (hi) w = (u32x4){0u, 0u, 0u, 0u}; qx = __builtin_bit_cast(bf16x8, w); }
    f32x16 O[2];
#pragma unroll
    for (int i = 0; i < 2; ++i)
#pragma unroll
        for (int j = 0; j < 16; ++j) O[i][j] = 0.f;
    float mrow = -1e30f, lrow = 0.f;
    const int key = tid >> 3, dc = tid & 7;
#define FOX_LOAD(kr, vr, fr_, kt) do { kr = *(const u32x4*)(Kp + (size_t)((kt) * 64 + key) * ldk + 8 * dc); vr = *(const u32x4*)(Vt + (size_t)key * ldvt + (kt) * 64 + 8 * dc); \
        if (tid < 64) fr_ = Fc[(kt) * 64 + tid] * L2E; } while (0)
#define FOX_STAGE(kr, vr, fr_, kt) do { LAS bf16_t* Ks_ = (LAS bf16_t*)(lds + ((kt) % NB) * BUFB); LAS bf16_t* Vs_ = Ks_ + 64 * KS; \
        *(LAS u32x4*)(Ks_ + key * KS + 8 * dc) = kr; *(LAS u32x4*)(Vs_ + key * VS + 8 * dc) = vr; \
        if (tid < 64) { const float F = fr_; const unsigned c1 = f2bf(F); const float r1 = F - bf1((bf16_t)c1); const unsigned c2 = f2bf(r1); const float r2 = r1 - bf1((bf16_t)c2); const unsigned c3 = f2bf(r2); \
            *(LAS u32x4*)(Ks_ + tid * KS + D) = (u32x4){0x3f80u | (0x3f80u << 16), 0x3f80u | ((c1 ^ 0x8000u) << 16), (c2 ^ 0x8000u) | ((c3 ^ 0x8000u) << 16), 0u}; \
            *(LAS u32x4*)(Ks_ + tid * KS + D + 8) = (u32x4){0u, 0u, 0u, 0u}; } } while (0)
    {
        u32x4 k4[4], v4[4]; float f4[4] = {0.f, 0.f, 0.f, 0.f};
#pragma unroll
        for (int j = 0; j < 4; ++j) FOX_LOAD(k4[j], v4[j], f4[j], tq + 3 - j);
#pragma unroll
        for (int j = 0; j < 4; ++j) FOX_STAGE(k4[j], v4[j], f4[j], tq + 3 - j);
    }
    u32x4 kreg, vreg; float fkreg = 0.f;
    if (tq - 1 >= kt0) FOX_LOAD(kreg, vreg, fkreg, tq - 1);
    __syncthreads();
    for (int i = 0; i < nsteps; ++i) {
        const int tl = tq - 1 - i;
        if (tl >= kt0) { FOX_STAGE(kreg, vreg, fkreg, tl); if (tl - 1 >= kt0) FOX_LOAD(kreg, vreg, fkreg, tl - 1); }
        const int t = dw - i;
        if (t >= ktw) {
            const LAS bf16_t* Ks = (const LAS bf16_t*)(lds + (t % NB) * BUFB); const LAS bf16_t* Vs = Ks + 64 * KS;
            attn_tile<64, true, KS, VS>(Ks, Vs, qf, qx, O, mrow, lrow, t * 64, q0w, r32, hi);
        }
        __syncthreads();
    }
#undef FOX_LOAD
#undef FOX_STAGE
    o_store_lds64(O, lrow, Op + (size_t)q0w * ldo, ldo, (LAS bf16_t*)(lds + wid * 4608), r32, hi, lane);
}

__device__ __forceinline__ void mem_unit(LAS unsigned char* lds, const bf16_t* Qp, const bf16_t* Kp, const bf16_t* Vt, const float* qg, const float* kg, bf16_t* Op, const int wv) {
    constexpr int D = 128, KS = D + 8, VS = 264, ldq = 512, ldk = 512, ldvt = 256, ldo = 512;
    constexpr float L2E = 1.4426950408889634f;
    const int tid = tid_from(wv);
    const int wid = wv, lane = tid & 63, r32 = lane & 31, hi = lane >> 5;
    LAS bf16_t* Ks = (LAS bf16_t*)lds; LAS bf16_t* Vs = Ks + 256 * KS;
    bf16x8 qw[8];
    { const bf16_t* qrow = Qp + (size_t)(wid * 32 + r32) * ldq + 8 * hi;
#pragma unroll
      for (int ks = 0; ks < 8; ++ks) qw[ks] = *(const bf16x8*)(qrow + 16 * ks); }
    {
#pragma unroll
      for (int rnd = 0; rnd < 2; ++rnd) { u32x4 kr[4], vr[4];
#pragma unroll
          for (int i = 0; i < 4; ++i) { const int ci = tid + 512 * (4 * rnd + i); const int key = ci >> 4, dc = ci & 15; kr[i] = *(const u32x4*)(Kp + (size_t)key * ldk + 8 * dc);
              const int d = ci >> 5, kc = ci & 31; vr[i] = *(const u32x4*)(Vt + (size_t)d * ldvt + 8 * kc); }
#pragma unroll
          for (int i = 0; i < 4; ++i) { const int ci = tid + 512 * (4 * rnd + i); const int key = ci >> 4, dc = ci & 15; *(LAS u32x4*)(Ks + key * KS + 8 * dc) = kr[i];
              const int d = ci >> 5, kc = ci & 31; *(LAS u32x4*)(Vs + d * VS + 8 * kc) = vr[i]; } } }
    __syncthreads();
    for (int qb = 0; qb < 4; ++qb) {
        bf16x8 qf[8];
#pragma unroll
        for (int ks = 0; ks < 8; ++ks) qf[ks] = qw[ks];
        if (qb + 1 < 4) { const bf16_t* qrow = Qp + (size_t)((qb + 1) * 256 + wid * 32 + r32) * ldq + 8 * hi;
#pragma unroll
            for (int ks = 0; ks < 8; ++ks) qw[ks] = *(const bf16x8*)(qrow + 16 * ks); }
        f32x16 O[4];
#pragma unroll
        for (int i = 0; i < 4; ++i)
#pragma unroll
            for (int j = 0; j < 16; ++j) O[i][j] = 0.f;
        float mrow = -1e30f, lrow = 0.f;
#pragma unroll 1
        for (int kt = 0; kt < 4; ++kt) attn_tile<128, false, KS, VS>(Ks + kt * 64 * KS, Vs + kt * 64, qf, qf[0], O, mrow, lrow, 0, 0, r32, hi);
        o_store<128>(O, lrow, Op + (size_t)(qb * 256 + wid * 32 + r32) * ldo, hi);
    }
    __syncthreads();
}

__device__ __forceinline__ void hgrn_unit(LAS unsigned char* lds, const bf16_t* hq, const bf16_t* hlf, const bf16_t* hi, const bf16_t* hg, const float* ng, bf16_t* ya, int b, int h, const int wv) {
    constexpr int QS = 136, TS = 72, OS = 132;
    LAS bf16_t* QD = (LAS bf16_t*)lds;
    LAS bf16_t* KD = QD + 64 * QS;
    LAS bf16_t* KDT = KD + 64 * QS;
    LAS bf16_t* IT = KDT + 128 * TS;
    LAS bf16_t* AM = IT + 128 * TS;
    LAS float* DV = (LAS float*)(AM + 64 * TS);
    LAS float* SEG = DV + 128;
    LAS float* OB = SEG + 512;
    const int tid = tid_from(wv);
    const int wid = wv, lane = tid & 63, fr = lane & 15, g = lane >> 4;
    const int c = tid & 127, sg = tid >> 7;
    const size_t rowbase = (size_t)b * NT;
    const size_t cbase = rowbase * 512 + h * 128 + c;
    f32x4 S[8];
#pragma unroll
    for (int i = 0; i < 8; ++i) S[i] = (f32x4){0.f, 0.f, 0.f, 0.f};
    bf16_t rq[16], rf[16], ri[16];
#pragma unroll
    for (int tt = 0; tt < 16; ++tt) { const size_t o = cbase + (size_t)(sg * 16 + tt) * 512; rq[tt] = hq[o]; rf[tt] = hlf[o]; ri[tt] = hi[o]; }
    for (int ch = 0; ch < NT / 64; ++ch) {
        float Gl[16]; float run = 0.f;
#pragma unroll
        for (int tt = 0; tt < 16; ++tt) { run += bf1(rf[tt]); Gl[tt] = run; }
        SEG[sg * 128 + c] = run;
        __syncthreads();
        float pre = 0.f, tot = 0.f;
#pragma unroll
        for (int s4 = 0; s4 < 4; ++s4) { const float v = SEG[s4 * 128 + c]; tot += v; if (s4 < sg) pre += v; }
        if (sg == 0) DV[c] = __expf(tot);
        unsigned kp[8], ip[8];
#pragma unroll
        for (int tt = 0; tt < 16; ++tt) { const float G = pre + Gl[tt]; const float qd = bf1(rq[tt]) * __expf(G); const float kd = (1.f - __expf(bf1(rf[tt]))) * __expf(-G);
            const unsigned qb = f2bf_hw(qd), kb = f2bf_hw(kd);
            QD[(16 * sg + tt) * QS + c] = (bf16_t)qb; KD[(16 * sg + tt) * QS + c] = (bf16_t)kb;
            if (tt & 1) { kp[tt >> 1] |= kb << 16; ip[tt >> 1] |= (unsigned)ri[tt] << 16; } else { kp[tt >> 1] = kb; ip[tt >> 1] = (unsigned)ri[tt]; } }
        *(LAS u32x4*)(KDT + c * TS + 16 * sg) = (u32x4){kp[0], kp[1], kp[2], kp[3]}; *(LAS u32x4*)(KDT + c * TS + 16 * sg + 8) = (u32x4){kp[4], kp[5], kp[6], kp[7]};
        *(LAS u32x4*)(IT + c * TS + 16 * sg) = (u32x4){ip[0], ip[1], ip[2], ip[3]}; *(LAS u32x4*)(IT + c * TS + 16 * sg + 8) = (u32x4){ip[4], ip[5], ip[6], ip[7]};
        if (ch + 1 < NT / 64) {
#pragma unroll
            for (int tt = 0; tt < 16; ++tt) { const size_t o = cbase + (size_t)((ch + 1) * 64 + sg * 16 + tt) * 512; rq[tt] = hq[o]; rf[tt] = hlf[o]; ri[tt] = hi[o]; }
        }
        __syncthreads();
        const size_t goff = (rowbase + ch * 64 + (tid >> 3)) * 512 + h * 128 + 16 * (tid & 7);
        const u32x4 g0 = *(const u32x4*)(hg + goff), g1 = *(const u32x4*)(hg + goff + 8);
#pragma unroll
        for (int bi = 0; bi < 2; ++bi) { const int idx = 2 * wid + bi, tb = idx >> 2, sb = idx & 3;
            f32x4 a = (f32x4){0.f, 0.f, 0.f, 0.f};
            if (sb <= tb) {
#pragma unroll
                for (int ks = 0; ks < 4; ++ks) { const bf16x8 qa = *(const LAS bf16x8*)(QD + (16 * tb + fr) * QS + 32 * ks + 8 * g); const bf16x8 kb = *(const LAS bf16x8*)(KD + (16 * sb + fr) * QS + 32 * ks + 8 * g);
                    a = __builtin_amdgcn_mfma_f32_16x16x32_bf16(qa, kb, a, 0, 0, 0); }
            }
#pragma unroll
            for (int e = 0; e < 4; ++e) { const int t = 16 * tb + 4 * g + e, sx = 16 * sb + fr; AM[t * TS + sx] = (bf16_t)f2bf_hw((sx <= t) ? a[e] : 0.f); } }
        __syncthreads();
        bf16x8 itf[2];
#pragma unroll
        for (int k2 = 0; k2 < 2; ++k2) itf[k2] = *(const LAS bf16x8*)(IT + (16 * wid + fr) * TS + 32 * k2 + 8 * g);
        bf16x8 sbf[4];
#pragma unroll
        for (int m4 = 0; m4 < 4; ++m4) { u32x4 w; w.x = pk2(S[2 * m4][0], S[2 * m4][1]); w.y = pk2(S[2 * m4][2], S[2 * m4][3]); w.z = pk2(S[2 * m4 + 1][0], S[2 * m4 + 1][1]); w.w = pk2(S[2 * m4 + 1][2], S[2 * m4 + 1][3]); sbf[m4] = __builtin_bit_cast(bf16x8, w); }
#pragma unroll
        for (int tb = 0; tb < 4; ++tb) { f32x4 O = (f32x4){0.f, 0.f, 0.f, 0.f};
#pragma unroll
            for (int k2 = 0; k2 < 2; ++k2) { const bf16x8 am = *(const LAS bf16x8*)(AM + (16 * tb + fr) * TS + 32 * k2 + 8 * g); O = __builtin_amdgcn_mfma_f32_16x16x32_bf16(am, itf[k2], O, 0, 0, 0); }
#pragma unroll
            for (int m4 = 0; m4 < 4; ++m4) { const u32x2 lo = *(const LAS u32x2*)(QD + (16 * tb + fr) * QS + 32 * m4 + 4 * g), hi2 = *(const LAS u32x2*)(QD + (16 * tb + fr) * QS + 32 * m4 + 16 + 4 * g);
                const u32x4 w = {lo.x, lo.y, hi2.x, hi2.y}; O = __builtin_amdgcn_mfma_f32_16x16x32_bf16(__builtin_bit_cast(bf16x8, w), sbf[m4], O, 0, 0, 0); }
#pragma unroll
            for (int e = 0; e < 4; ++e) OB[(16 * tb + 4 * g + e) * OS + 16 * wid + fr] = O[e]; }
#pragma unroll
        for (int blk = 0; blk < 8; ++blk) {
#pragma unroll
            for (int k2 = 0; k2 < 2; ++k2) { const bf16x8 kt = *(const LAS bf16x8*)(KDT + (16 * blk + fr) * TS + 32 * k2 + 8 * g); S[blk] = __builtin_amdgcn_mfma_f32_16x16x32_bf16(kt, itf[k2], S[blk], 0, 0, 0); }
            const f32x4 dvv = *(const LAS f32x4*)(DV + 16 * blk + 4 * g); S[blk] = S[blk] * dvv; }
        __syncthreads();
        { const int t = tid >> 3, part = tid & 7; const LAS float* op = OB + t * OS + 16 * part;
            const f32x4 o0 = *(const LAS f32x4*)op, o1 = *(const LAS f32x4*)(op + 4), o2 = *(const LAS f32x4*)(op + 8), o3 = *(const LAS f32x4*)(op + 12);
            float sq = (o0[0] * o0[0] + o0[1] * o0[1] + o0[2] * o0[2] + o0[3] * o0[3]) + (o1[0] * o1[0] + o1[1] * o1[1] + o1[2] * o1[2] + o1[3] * o1[3])
                     + (o2[0] * o2[0] + o2[1] * o2[1] + o2[2] * o2[2] + o2[3] * o2[3]) + (o3[0] * o3[0] + o3[1] * o3[1] + o3[2] * o3[2] + o3[3] * o3[3]);
            sq += sxor<1>(sq); sq += sxor<2>(sq); sq += sxor<4>(sq);
            const float rs = __builtin_amdgcn_rsqf(sq * (1.f / 128.f) + EPS);
            const size_t off = (rowbase + ch * 64 + t) * 512 + h * 128 + 16 * part;
            const f32x4 n0 = *(const f32x4*)(ng + 16 * part), n1 = *(const f32x4*)(ng + 16 * part + 4), n2 = *(const f32x4*)(ng + 16 * part + 8), n3 = *(const f32x4*)(ng + 16 * part + 12);
            u32x4 w0, w1;
            w0.x = pk2(o0[0] * rs * n0[0] * bflo(g0.x), o0[1] * rs * n0[1] * bfhi(g0.x)); w0.y = pk2(o0[2] * rs * n0[2] * bflo(g0.y), o0[3] * rs * n0[3] * bfhi(g0.y));
            w0.z = pk2(o1[0] * rs * n1[0] * bflo(g0.z), o1[1] * rs * n1[1] * bfhi(g0.z)); w0.w = pk2(o1[2] * rs * n1[2] * bflo(g0.w), o1[3] * rs * n1[3] * bfhi(g0.w));
            w1.x = pk2(o2[0] * rs * n2[0] * bflo(g1.x), o2[1] * rs * n2[1] * bfhi(g1.x)); w1.y = pk2(o2[2] * rs * n2[2] * bflo(g1.y), o2[3] * rs * n2[3] * bfhi(g1.y));
            w1.z = pk2(o3[0] * rs * n3[0] * bflo(g1.z), o3[1] * rs * n3[1] * bfhi(g1.z)); w1.w = pk2(o3[2] * rs * n3[2] * bflo(g1.w), o3[3] * rs * n3[3] * bfhi(g1.w));
            *(u32x4*)(ya + off) = w0; *(u32x4*)(ya + off + 8) = w1; }
    }
    __syncthreads();
}

__device__ __forceinline__ void grid_bar(unsigned* cnt, unsigned target, const int wv) {
    __syncthreads();
    if (tid_from(wv) == 0) {
        unsigned* flag = cnt + 32;
        const unsigned gen = target / gridDim.x;
        __builtin_amdgcn_fence(__ATOMIC_RELEASE, "agent");
        const unsigned old = __hip_atomic_fetch_add(cnt, 1u, __ATOMIC_RELAXED, __HIP_MEMORY_SCOPE_AGENT);
        if (old == target - 1u) __hip_atomic_store(flag, gen, __ATOMIC_RELAXED, __HIP_MEMORY_SCOPE_AGENT);
        else while (__hip_atomic_load(flag, __ATOMIC_RELAXED, __HIP_MEMORY_SCOPE_AGENT) < gen) __builtin_amdgcn_s_sleep(4);
        __builtin_amdgcn_fence(__ATOMIC_ACQUIRE, "agent");
    }
    __syncthreads();
}

__global__ void __launch_bounds__(512, 2) fwd_mega(Params P) {
    extern __shared__ __attribute__((aligned(16))) unsigned char lds_raw[];
    LAS unsigned char* lds = (LAS unsigned char*)lds_raw;
    cg::grid_group grid = cg::this_grid();
    const int wv = __builtin_amdgcn_readfirstlane((int)threadIdx.x >> 6);
#define tid (tid_from(wv))
#define lane (lane_id())
#define wid wv
    const int G = gridDim.x, bx = blockIdx.x;
#define ws (P.ws)
#define x (P.in[0])
#define mem (P.in[1])
#define norm_mix_g (P.in[2])
#define norm_mem_g (P.in[3])
#define w_in (P.in[4])
#define lb_logits (P.in[5])
#define hgrn_norm_g (P.in[6])
#define fox_f_bias (P.in[7])
#define fox_q_g (P.in[8])
#define fox_k_g (P.in[9])
#define mem_kv_w (P.in[10])
#define mem_q_g (P.in[11])
#define mem_k_g (P.in[12])
#define w_br_h (P.in[13])
#define w_br_f (P.in[14])
#define w_br_m (P.in[15])
#define w_out (P.in[16])
#define norm_ffn_g (P.in[17])
#define w_up (P.in[18])
#define conv_w (P.in[19])
#define conv_b (P.in[20])
#define w_down (P.in[21])
#define out (P.out)
#define ctl ((unsigned*)(ws + WS_CTL * MiB))
#define WCAT ((bf16_t*)(ws + WS_WCAT * MiB))
#define WBR ((bf16_t*)(ws + WS_WBR * MiB))
#define WOUT ((bf16_t*)(ws + WS_WOUT * MiB))
#define WUP ((bf16_t*)(ws + WS_WUP * MiB))
#define WDOWN ((bf16_t*)(ws + WS_WDOWN * MiB))
#define FLOG ((float*)(ws + WS_FLOG * MiB))
#define FC ((float*)(ws + WS_FC * MiB))
#define SS ((float*)(ws + WS_SS * MiB))
#define MEMK ((bf16_t*)(ws + WS_MEMK * MiB))
#define MEMVT ((bf16_t*)(ws + WS_MEMVT * MiB))
#define Z ((bf16_t*)(ws + WS_Z * MiB))
#define GATES ((bf16_t*)(ws + WS_GATES * MiB))
#define ACC32 ((float*)(ws + WS_ACC32 * MiB))
#define MERGED ((bf16_t*)(ws + WS_MERGED * MiB))
#define X1B ((bf16_t*)(ws + WS_X1B * MiB))
#define Y ((bf16_t*)(ws + WS_Y * MiB))
#define HCAT ((bf16_t*)out)
#define YABC ((bf16_t*)out)
    const size_t ZS = (size_t)MTOK * 512;

#ifndef NO_P0
#ifdef DUP_P0
    for (int rep0 = 0; rep0 < 2; ++rep0)
#endif
    {
        if (bx == 0 && tid == 0) { ctl[0] = 0u; ctl[1] = 0u; ctl[64] = 0u; ctl[96] = 0u; }
        if (bx == 0 && tid < 384) { const int t_ = tid; float* gt = (float*)(ctl + 2048); gt[t_] = t_ < 64 ? fox_q_g[t_] : (t_ < 128 ? fox_k_g[t_ - 64] : (t_ < 256 ? mem_q_g[t_ - 128] : mem_k_g[t_ - 256])); }
        LAS float* ffw = (LAS float*)(lds + 73728);
        for (int idx = tid; idx < 8192; idx += 512) { const int k = idx >> 3, jj = idx & 7; ffw[jj * 1024 + k] = w_in[(size_t)k * INC + 3584 + jj]; }
        __syncthreads();
        LAS float* scr = (LAS float*)(lds + wid * 8448);
        const int gw = bx * 8 + wid, NGW = G * 8;
        constexpr int I0 = 16 * 224, I1 = 16 * 32, I2 = 8 * 32, I3 = 16 * 32, I4 = 16 * 176, I5 = 44 * 32;
        constexpr int NIT = I0 + I1 + 3 * I2 + I3 + I4 + I5;
        for (int it = gw; it < NIT; it += NGW) {
            int r = it;
            if (r < I0) { const int kb = r / 224, nb = r % 224, n0 = nb * 32; transpose_item(w_in, INC, 1024, WCAT, n0, n0 < 3584 ? n0 : n0 + 8, kb * 64, nullptr, scr, lane); continue; } r -= I0;
            if (r < I1) { const int kb = r / 32, nb = r % 32; transpose_item(mem_kv_w, 1024, 1024, WCAT + (size_t)7168 * 1024, nb * 32, nb * 32, kb * 64, nullptr, scr, lane); continue; } r -= I1;
            if (r < 3 * I2) { const int j = r / I2, rr = r % I2, kb = rr / 32, nb = rr % 32; const float* W = j == 0 ? w_br_h : (j == 1 ? w_br_f : w_br_m);
                transpose_item(W, 1024, 512, WBR + (size_t)j * 1024 * 512, nb * 32, nb * 32, kb * 64, nullptr, scr, lane); continue; } r -= 3 * I2;
            if (r < I3) { const int kb = r / 32, nb = r % 32; transpose_item(w_out, 1024, 1024, WOUT, nb * 32, nb * 32, kb * 64, nullptr, scr, lane); continue; } r -= I3;
            if (r < I4) { const int kb = r / 176, nb = r % 176, n0 = nb * 32; const int pn = n0 >> 8, bj = (n0 >> 7) & 1, cc = n0 & 127;
                transpose_item(w_up, 2 * FFD, 1024, WUP, n0, bj * FFD + 128 * pn + cc, kb * 64, norm_ffn_g, scr, lane); continue; } r -= I4;
            { const int kb = r / 32, nb = r % 32; transpose_item(w_down, 1024, FFD, WDOWN, nb * 32, nb * 32, kb * 64, nullptr, scr, lane); }
        }
        norm_rows<true>(x, MTOK, gw, NGW, norm_mix_g, HCAT, ffw, fox_f_bias, FLOG, lane);
        norm_rows<false>(mem, MMEM, gw, NGW, norm_mem_g, HCAT + (size_t)MTOK * DM, ffw, nullptr, nullptr, lane);
    }
#endif
    grid.sync();

#ifndef NO_P1
    {
        LAS float* wt = (LAS float*)(lds + LDS_X); LAS float* FcL = (LAS float*)(lds + LDS_X + 1024);
        for (int bh = bx; bh < 256; bh += G) { const int b = bh >> 3, h = bh & 7;
            float v[4]; float run = 0.f;
#pragma unroll
            for (int e = 0; e < 4; ++e) { run += FLOG[((size_t)b * NT + 4 * tid + e) * 8 + h]; v[e] = run; }
            float inc = run;
#pragma unroll
            for (int o = 1; o < 64; o <<= 1) { const int l_ = lane_id(); const float t = __int_as_float(__builtin_amdgcn_ds_bpermute((l_ - o) << 2, __float_as_int(inc))); if (l_ >= o) inc += t; }
            if (lane == 63) wt[wid] = inc;
            __syncthreads();
            float pre = inc - run;
            for (int w = 0; w < wid; ++w) pre += wt[w];
            const f32x4 fc4 = {pre + v[0], pre + v[1], pre + v[2], pre + v[3]};
            *(f32x4*)(FC + (size_t)bh * NT + 4 * tid) = fc4; *(LAS f32x4*)(FcL + 4 * tid) = fc4;
            __syncthreads();
            { float gq = fabsf(fox_q_g[lane]), gk = fabsf(fox_k_g[lane]);
                gq = xmax64(gq); gk = xmax64(gk);
                const float L2 = 2.f * 8.f * 1.02f * gq * gk;
                const int l_ = lane;
                for (int i = 0; i < 8; ++i) { const int rb = 8 * wid + i; bool skip = false;
                    if (l_ < ((rb >> 1) + 1)) skip = (L2 + FcL[32 * rb] - FcL[64 * l_ + 63]) * 1.4426950408889634f < -127.f;
                    const int k0t = __builtin_popcountll(__ballot(skip));
                    if (l_ == 0) ((int*)ctl)[4096 + bh * 64 + rb] = k0t; } }
            __syncthreads();
        }
        SchedIn S{G, bx, (const char*)HCAT, (const char*)WCAT};
        EpiIn E{Z, GATES, MEMK, MEMVT, lb_logits, (const float*)(ctl + 2048), (LAS float*)(lds + LDS_X + 8192)};
#ifdef DUP_P1
        pg8::gemm_phase<EpiIn, SchedIn>(lds, 1024, S, E, wv);
#endif
        pg8::gemm_phase<EpiIn, SchedIn>(lds, 1024, S, E, wv);
    }
#endif
    grid_bar(ctl + 64, 1u * (unsigned)G, wv);

#ifndef NO_P2
    {
        LAS int* slot = (LAS int*)(lds + LDS_BYTES - 64);
#ifdef DUP_P2
        for (int rep = 0; rep < 2; ++rep)
#else
        const int rep = 0;
#endif
        __syncthreads();
        if (tid == 0) *slot = (int)atomicAdd(ctl + rep, 1u);
        for (;;) {
            __syncthreads();
            const int it = *slot;
            if (it >= 128 + 256 + 2048) break;
            unsigned nxt = 0u;
            if (tid == 0) nxt = atomicAdd(ctl + rep, 1u);
            __syncthreads();
            if (it < 128) { hgrn_unit(lds, Z + 0 * ZS, Z + 1 * ZS, Z + 2 * ZS, Z + 3 * ZS, hgrn_norm_g, YABC, it >> 2, it & 3, wv); }
            else if (it < 128 + 256) { const int r = it - 128, half = r & 1, bh = r >> 1, b = bh >> 2, h = bh & 3;
                mem_unit(lds, Z + 7 * ZS + ((size_t)b * NT + half * 1024) * 512 + h * 128, MEMK + (size_t)b * NMEM * 512 + h * 128, MEMVT + (size_t)bh * 128 * 256, mem_q_g, mem_k_g,
                         YABC + 2 * ZS + ((size_t)b * NT + half * 1024) * 512 + h * 128, wv); }
            else { const int r = it - 128 - 256, qb = 7 - (r >> 8), bh = r & 255, b = bh >> 3, h = bh & 7;
                fox_unit(lds, Z + 4 * ZS + (size_t)b * NT * 512 + h * 64, Z + 5 * ZS + (size_t)b * NT * 512 + h * 64, Z + 6 * ZS + (size_t)bh * 64 * 2048, fox_q_g, fox_k_g, FC + (size_t)bh * NT, qb * 256, 4 * (qb + 1), (const int*)ctl + 4096 + bh * 64,
                         YABC + ZS + (size_t)b * NT * 512 + h * 64, wv); }
            if (tid == 0) *slot = (int)nxt;
        }
    }
#endif
    grid_bar(ctl + 64, 2u * (unsigned)G, wv);

#ifndef NO_P3
    for (int p = bx; p < 256; p += G) {
        {
            SchedMerge S{p, (const char*)YABC, (const char*)WBR};
            EpiMerge E{GATES, (bf16_t*)ACC32, MERGED};
            pg8::gemm_phase<EpiMerge, SchedMerge>(lds, 512, S, E, wv);
        }
        __syncthreads();
        {
            SchedPanel S{p, (const char*)MERGED, (const char*)WOUT, 2048};
            EpiOut E{x, X1B, SS, (LAS float*)(lds + LDS_X + 8192), wv};
            pg8::gemm_phase<EpiOut, SchedPanel>(lds, 1024, S, E, wv);
        }
    }
#endif
    grid_bar(ctl + 64, 3u * (unsigned)G, wv);

#ifndef NO_P5
    {
        SchedPlain S{G, bx, 259, 22, 254, -2, (const char*)X1B, (const char*)WUP, 2048};
        EpiUp E{SS, conv_w, conv_b, Y, (LAS float*)(lds + LDS_X + 256)};
#ifdef DUP_P5
        pg8::gemm_phase<EpiUp, SchedPlain>(lds, 1024, S, E, wv);
#endif
        pg8::gemm_phase<EpiUp, SchedPlain>(lds, 1024, S, E, wv);
    }
#endif
    grid_bar(ctl + 64, 4u * (unsigned)G, wv);
#ifdef PROBE_BAR
    grid_bar(ctl + 64, 5u * (unsigned)G, wv); grid_bar(ctl + 64, 6u * (unsigned)G, wv); grid_bar(ctl + 64, 7u * (unsigned)G, wv); grid_bar(ctl + 64, 8u * (unsigned)G, wv); grid_bar(ctl + 64, 9u * (unsigned)G, wv);
#endif

#ifndef NO_P6
    {
        SchedPlain S{G, bx, 256, 4, 256, 0, (const char*)Y, (const char*)WDOWN, 2 * FFD};
        EpiDown E{X1B, out};
        pg8::gemm_phase<EpiDown, SchedPlain>(lds, FFD, S, E, wv);
    }
#endif
}

#undef tid
#undef lane
#undef wid
#undef ws
#undef x
#undef mem
#undef norm_mix_g
#undef norm_mem_g
#undef w_in
#undef lb_logits
#undef hgrn_norm_g
#undef fox_f_bias
#undef fox_q_g
#undef fox_k_g
#undef mem_kv_w
#undef mem_q_g
#undef mem_k_g
#undef w_br_h
#undef w_br_f
#undef w_br_m
#undef w_out
#undef norm_ffn_g
#undef w_up
#undef conv_w
#undef conv_b
#undef w_down
#undef out
#undef ctl
#undef WCAT
#undef WBR
#undef WOUT
#undef WUP
#undef WDOWN
#undef FLOG
#undef FC
#undef SS
#undef MEMK
#undef MEMVT
#undef Z
#undef GATES
#undef ACC32
#undef MERGED
#undef X1B
#undef Y
#undef HCAT
#undef YABC
extern "C" void kernel_launch(void* const* d_in, const int* in_sizes, int n_in, void* d_out, int out_size, void* d_ws, size_t ws_size, hipStream_t stream) {
    static int grid = 0;
    if (grid == 0) {
        int dev = 0, cus = 0, per_cu = 0;
        hipGetDevice(&dev);
        hipDeviceGetAttribute(&cus, hipDeviceAttributeMultiprocessorCount, dev);
        hipFuncSetAttribute((const void*)fwd_mega, hipFuncAttributeMaxDynamicSharedMemorySize, LDS_BYTES);
        hipOccupancyMaxActiveBlocksPerMultiprocessor(&per_cu, (const void*)fwd_mega, 512, LDS_BYTES);
        if (per_cu < 1) per_cu = 1;
        grid = cus * per_cu;
        (void)hipGetLastError();
    }
    Params p{};
    for (int i = 0; i < 22; ++i) p.in[i] = (const float*)d_in[i];
    p.out = (float*)d_out; p.ws = (unsigned char*)d_ws;
    void* args[] = {&p};
    hipError_t e = hipLaunchCooperativeKernel((const void*)fwd_mega, dim3(grid), dim3(512), args, LDS_BYTES, stream);
    if (e != hipSuccess) fprintf(stderr, "cooperative launch failed: %s (grid %d)\n", hipGetErrorString(e), grid);
}
```

```cpp
#include <hip/hip_runtime.h>
#include <hip/hip_cooperative_groups.h>
#include <cstdio>
#include <cstdint>
namespace cg = cooperative_groups;

#define LAS __attribute__((address_space(3)))
typedef unsigned short bf16_t;
typedef short bf16x8 __attribute__((ext_vector_type(8)));
typedef float f32x4 __attribute__((ext_vector_type(4)));
typedef float f32x2 __attribute__((ext_vector_type(2)));
typedef unsigned u32x4 __attribute__((ext_vector_type(4)));
typedef unsigned u32x2 __attribute__((ext_vector_type(2)));

constexpr int NB = 32, NT = 2048, DM = 1024, MTOK = NB * NT, NMEM = 256, MMEM = NB * NMEM;
constexpr int INC = 7176, FFD = 2816;
constexpr float EPS = 1e-6f;
constexpr size_t MiB = 1u << 20;
constexpr size_t WS_CTL = 0, WS_WCAT = 1, WS_WBR = 17, WS_WOUT = 20, WS_WUP = 22, WS_WDOWN = 33, WS_FLOG = 40, WS_FC = 42, WS_SS = 44,
                 WS_MEMK = 48, WS_MEMVT = 56, WS_Z = 64, WS_GATES = 576, WS_ACC32 = 64, WS_MERGED = 320, WS_X1B = 448, WS_Y = 600;
constexpr int LDS_BYTES = 147456;
constexpr int LDS_X = 131072;

__device__ __forceinline__ unsigned f2bf(float f) { unsigned u = __builtin_bit_cast(unsigned, f); return (u + 0x7fffu + ((u >> 16) & 1u)) >> 16; }
typedef __bf16 bf16x2_t __attribute__((ext_vector_type(2)));
__device__ __forceinline__ unsigned pk2(float lo, float hi) { const f32x2 v = {lo, hi}; const bf16x2_t b = __builtin_convertvector(v, bf16x2_t); return __builtin_bit_cast(unsigned, b); }
__device__ __forceinline__ unsigned f2bf_hw(float f) { return pk2(f, 0.f) & 0xffffu; }
__device__ __forceinline__ float bflo(unsigned u) { return __builtin_bit_cast(float, u << 16); }
__device__ __forceinline__ float bfhi(unsigned u) { return __builtin_bit_cast(float, u & 0xffff0000u); }
__device__ __forceinline__ float bf1(bf16_t u) { return __builtin_bit_cast(float, (unsigned)u << 16); }
__device__ __forceinline__ int lane_id() { int l = (int)__builtin_amdgcn_mbcnt_hi(~0u, __builtin_amdgcn_mbcnt_lo(~0u, 0u)); asm volatile("" : "+v"(l)); return l; }
__device__ __forceinline__ int tid_from(int wv) { return wv * 64 + lane_id(); }
template <int O> __device__ __forceinline__ float sxor(float v) {
    if constexpr (O == 32) { auto rr = __builtin_amdgcn_permlane32_swap(__float_as_uint(v), __float_as_uint(v), false, false); const unsigned a = rr[0], b = rr[1]; return (lane_id() & 32) ? __uint_as_float(a) : __uint_as_float(b); }
    else return __int_as_float(__builtin_amdgcn_ds_swizzle(__float_as_int(v), (O << 10) | 0x1f));
}
__device__ __forceinline__ float xsum64(float v) { v += sxor<1>(v); v += sxor<2>(v); v += sxor<4>(v); v += sxor<8>(v); v += sxor<16>(v); v += sxor<32>(v); return v; }
__device__ __forceinline__ float xmax64(float v) { v = fmaxf(v, sxor<1>(v)); v = fmaxf(v, sxor<2>(v)); v = fmaxf(v, sxor<4>(v)); v = fmaxf(v, sxor<8>(v)); v = fmaxf(v, sxor<16>(v)); v = fmaxf(v, sxor<32>(v)); return v; }
__device__ __forceinline__ float wave_sum(float v) { return xsum64(v); }
__device__ __forceinline__ float sigmoidf_(float x) { return __builtin_amdgcn_rcpf(1.f + __builtin_amdgcn_exp2f(x * -1.4426950408889634f)); }

namespace pg8 {
constexpr int BM = 256, BK = 64, HALF = 128, HTB = HALF * BK * 2, NXCD = 8, WGM = 8;
__host__ __device__ __forceinline__ int lds_byte(int r, int c) { const int st = (r >> 4) * 2 + (c >> 5), rr = r & 15, cc = c & 31, ob = rr * 64 + cc * 2; return st * 1024 + (ob ^ (((ob >> 9) & 1) << 5)); }
__host__ __device__ __forceinline__ void stage_rc(int b, int& R, int& C) { const int st = b / 1024, sb = b % 1024, swz = sb ^ (((sb >> 9) & 1) << 5); R = (st >> 1) * 16 + swz / 64; C = (st & 1) * 32 + (swz % 64) / 2; }
__host__ __device__ __forceinline__ int perm32(int rho) { const int n = rho >> 4, i = rho & 15; return 8 * (i >> 2) + 4 * n + (i & 3); }
struct Unit { int pm, pn; };
struct Gemm { const bf16_t* A; const bf16_t* Bt; int K; };
__device__ __forceinline__ void swz_unit(int L, int nM, int nN, Unit& u) {
    int wgid = L; const int nwg = nM * nN; { const int q = nwg / NXCD, r = nwg % NXCD, xcd = wgid % NXCD, off = wgid / NXCD; wgid = (xcd < r ? xcd * (q + 1) : r * (q + 1) + (xcd - r) * q) + off; }
    const int nig = WGM * nN, gid = wgid / nig, fm = gid * WGM, gsz = (nM - fm) < WGM ? (nM - fm) : WGM;
    u.pm = fm + ((wgid % nig) % gsz); u.pn = (wgid % nig) / gsz;
}
__device__ __forceinline__ unsigned cvt_pk_bf16(float lo, float hi) { unsigned r; asm volatile("v_cvt_pk_bf16_f32 %0, %1, %2" : "=v"(r) : "v"(lo), "v"(hi)); return r; }
__device__ __forceinline__ f32x2 gelu_pk(f32x2 x) {
    const f32x2 u0 = x * 0.70710678f; f32x2 u; u.x = __builtin_amdgcn_fmed3f(u0.x, -3.2f, 3.2f); u.y = __builtin_amdgcn_fmed3f(u0.y, -3.2f, 3.2f);
    const f32x2 t = (u * u) * 0.1953125f - 1.0f;
    f32x2 p = t * 2.982273671e-03f + (-7.046153472e-03f);
    p = p * t + 7.957076705e-03f; p = p * t + (-1.521942819e-02f); p = p * t + 3.318292224e-02f; p = p * t + (-5.471928813e-02f); p = p * t + 8.062700147e-02f;
    p = p * t + (-1.136467381e-01f); p = p * t + 1.543549678e-01f; p = p * t + (-2.173077339e-01f); p = p * t + 4.413341836e-01f;
    const f32x2 e = u * p, hx = x * 0.5f;
    return hx + hx * e;
}

template <class Epi, class Sched>
__device__ __forceinline__ void gemm_phase(LAS unsigned char* lds, const int K, const Sched& S, const Epi& E, const int wv) {
    const int tid = tid_from(wv);
    const int wid = wv, lane = tid & 63, wr = wid >> 2, wc = wid & 3, fr = lane & 15, fq = lane >> 4;
    const int nt = K / BK;
    unsigned voffA[2], voffB[2];
#pragma unroll
    for (int i = 0; i < 2; ++i) { int R, C; stage_rc(tid * 16 + i * 8192, R, C); const int Rb = (R & ~31) + perm32(R & 31);
        voffA[i] = (unsigned)(R * K + C) * 2u; voffB[i] = (unsigned)(Rb * K + C) * 2u; }
    const size_t kstep = (size_t)(BK * 2);
    const size_t hstep = (size_t)HALF * K * 2;
    const unsigned ldsw = (unsigned)wid * 1024u;
    const int aoff = lds_byte(wr * 64 + fr, fq * 8), boff = lds_byte(wc * 32 + fr, fq * 8);
#define PG8_SA(b, h) (((b) * 2 + (h)) * HTB)
#define PG8_SB(b, h) ((4 + (b) * 2 + (h)) * HTB)
#define PG8_STAGE(bufoff, gbase, voff) do { _Pragma("unroll") for (int _i = 0; _i < 2; ++_i) \
        __builtin_amdgcn_global_load_lds((const unsigned*)((const char*)(gbase) + (voff)[_i]), (LAS unsigned*)(lds + (bufoff) + ldsw + _i * 8192), 16, 0, 0); } while (0)
#define PG8_LDA(dst, b, h) do { _Pragma("unroll") for (int m = 0; m < 4; ++m) _Pragma("unroll") for (int k = 0; k < 2; ++k) dst[m][k] = *(const LAS bf16x8*)(lds + PG8_SA(b, h) + aoff + m * 2048 + k * 1024); } while (0)
#define PG8_LDB(dst, b, h) do { _Pragma("unroll") for (int n = 0; n < 2; ++n) _Pragma("unroll") for (int k = 0; k < 2; ++k) dst[n][k] = *(const LAS bf16x8*)(lds + PG8_SB(b, h) + boff + n * 2048 + k * 1024); } while (0)
#define PG8_MMA(ai, bj, At, Bt) do { __builtin_amdgcn_s_setprio(1); _Pragma("unroll") for (int m = 0; m < 4; ++m) _Pragma("unroll") for (int n = 0; n < 2; ++n) _Pragma("unroll") for (int k = 0; k < 2; ++k) \
        acc[ai][bj][m][n] = __builtin_amdgcn_mfma_f32_16x16x32_bf16(Bt[n][k], At[m][k], acc[ai][bj][m][n], 0, 0, 0); __builtin_amdgcn_s_setprio(0); } while (0)
#define PG8_WAIT_V(n) asm volatile("s_waitcnt vmcnt(" #n ")" ::: "memory")
#define PG8_WAIT_L(n) asm volatile("s_waitcnt lgkmcnt(" #n ")" ::: "memory")
#define PG8_BAR __builtin_amdgcn_s_barrier()
#define PG8_SCHED __builtin_amdgcn_sched_barrier(0)
    Unit cur, nxt; int ui = 0;
    if (!S.next(0, cur)) return;
    cur.pm = __builtin_amdgcn_readfirstlane(cur.pm); cur.pn = __builtin_amdgcn_readfirstlane(cur.pn);
    f32x4 acc[2][2][4][2];
#pragma unroll
    for (int a = 0; a < 2; ++a)
#pragma unroll
        for (int b = 0; b < 2; ++b)
#pragma unroll
            for (int m = 0; m < 4; ++m)
#pragma unroll
                for (int n = 0; n < 2; ++n) acc[a][b][m][n] = (f32x4){0.f, 0.f, 0.f, 0.f};
    bf16x8 At[4][2], B0[2][2], B1[2][2];
    const char* cA = S.aptr(cur); const char* cB = S.bptr(cur);
    PG8_STAGE(PG8_SB(0, 0), cB, voffB); PG8_STAGE(PG8_SB(0, 1), cB + hstep, voffB); PG8_STAGE(PG8_SA(0, 0), cA, voffA); PG8_STAGE(PG8_SA(0, 1), cA + hstep, voffA);
    if (wr == 1) PG8_BAR;
    PG8_WAIT_V(2); PG8_BAR;
    PG8_STAGE(PG8_SB(1, 0), cB + kstep, voffB); PG8_STAGE(PG8_SA(1, 0), cA + kstep, voffA); PG8_STAGE(PG8_SB(1, 1), cB + hstep + kstep, voffB);
    PG8_WAIT_V(6); PG8_BAR;
    for (;;) {
        const bool has_next = S.next(ui + 1, nxt);
        nxt.pm = __builtin_amdgcn_readfirstlane(nxt.pm); nxt.pn = __builtin_amdgcn_readfirstlane(nxt.pn);
        const char* nA = has_next ? S.aptr(nxt) : cA; const char* nB = has_next ? S.bptr(nxt) : cB;
        for (int t = 0; t < nt; t += 2) {
            const bool last = (t == nt - 2);
            const char* a1 = cA + (size_t)(t + 1) * kstep;
            const char* a2 = last ? nA : cA + (size_t)(t + 2) * kstep; const char* b2 = last ? nB : cB + (size_t)(t + 2) * kstep;
            const char* a3 = a2 + kstep; const char* b3 = b2 + kstep;
            PG8_LDB(B0, 0, 0); PG8_LDB(B1, 0, 1); PG8_SCHED; PG8_LDA(At, 0, 0); PG8_STAGE(PG8_SA(1, 1), a1 + hstep, voffA);
            PG8_WAIT_V(8); PG8_WAIT_L(0); PG8_BAR; PG8_MMA(0, 0, At, B0); PG8_MMA(0, 1, At, B1); PG8_BAR; PG8_SCHED;
            PG8_LDA(At, 0, 1); PG8_STAGE(PG8_SB(0, 0), b2, voffB); PG8_STAGE(PG8_SB(0, 1), b2 + hstep, voffB); PG8_STAGE(PG8_SA(0, 0), a2, voffA);
            PG8_WAIT_V(8); PG8_WAIT_L(0); PG8_BAR; PG8_MMA(1, 0, At, B0); PG8_MMA(1, 1, At, B1); PG8_BAR; PG8_SCHED;
            PG8_LDB(B0, 1, 0); PG8_LDB(B1, 1, 1); PG8_SCHED; PG8_LDA(At, 1, 0); PG8_STAGE(PG8_SA(0, 1), a2 + hstep, voffA);
            PG8_WAIT_V(8); PG8_WAIT_L(0); PG8_BAR; PG8_MMA(0, 0, At, B0); PG8_MMA(0, 1, At, B1); PG8_BAR; PG8_SCHED;
            PG8_LDA(At, 1, 1); PG8_STAGE(PG8_SB(1, 0), b3, voffB); PG8_STAGE(PG8_SB(1, 1), b3 + hstep, voffB); PG8_STAGE(PG8_SA(1, 0), a3, voffA);
            PG8_WAIT_V(8); PG8_WAIT_L(0); PG8_BAR; PG8_MMA(1, 0, At, B0); PG8_MMA(1, 1, At, B1); PG8_BAR; PG8_SCHED;
        }
        if (wr == 0) PG8_BAR;
        E(acc, cur, wr, wc, fr, fq);
        if (!has_next) break;
#pragma unroll
        for (int a = 0; a < 2; ++a)
#pragma unroll
            for (int b = 0; b < 2; ++b)
#pragma unroll
                for (int m = 0; m < 4; ++m)
#pragma unroll
                    for (int n = 0; n < 2; ++n) acc[a][b][m][n] = (f32x4){0.f, 0.f, 0.f, 0.f};
        cur = nxt; cA = nA; cB = nB; ++ui;
        if (wr == 1) PG8_BAR;
    }
    PG8_WAIT_V(0);
    PG8_BAR;
#undef PG8_SA
#undef PG8_SB
#undef PG8_STAGE
#undef PG8_LDA
#undef PG8_LDB
#undef PG8_MMA
#undef PG8_WAIT_V
#undef PG8_WAIT_L
#undef PG8_BAR
#undef PG8_SCHED
}
}
using pg8::Unit;
typedef f32x4 (&AccRef)[2][2][4][2];

struct SchedIn {
    int G, c; const char* H; const char* W;
    __device__ __forceinline__ bool next(int i, Unit& u) const {
        int L = i * G + c;
        if (L < 6656) { pg8::swz_unit(L, 256, 26, u); u.pn = u.pn < 12 ? u.pn : u.pn + 2; return true; }
        L -= 6656;
        if (L < 512) { u.pm = 1024 + (L & 1); u.pn = L >> 1; return true; }
        L -= 512;
        if (L < 64) { u.pm = 2048 + (L >> 1); u.pn = 28 + (L & 1); return true; }
        L -= 64;
        if (L < 64) { u.pm = 3072 + (L & 1); u.pn = L >> 1; return true; }
        return false;
    }
    __device__ __forceinline__ const char* aptr(const Unit& u) const { const int ty = u.pm >> 10, idx = u.pm & 1023;
        const long row = ty == 0 ? (long)idx * 256 : (ty == 1 ? (long)(12 + idx) * 256 : (ty == 2 ? (long)MTOK + idx * 256 : (long)(30 + idx) * 256));
        return ((ty & 1) ? W : H) + row * 2048; }
    __device__ __forceinline__ const char* bptr(const Unit& u) const { const int ty = u.pm >> 10;
        const long row = ty == 3 ? (long)MTOK + u.pn * 256 : (long)u.pn * 256;
        return ((ty & 1) ? H : W) + row * 2048; }
};
struct SchedMerge {
    int p; const char* A; const char* B;
    __device__ __forceinline__ bool next(int i, Unit& u) const {
        if (i >= 12) return false; const int pn = i / 3, j = i - 3 * pn; u.pm = j * 256 + p; u.pn = j * 4 + pn; return true;
    }
    __device__ __forceinline__ const char* aptr(const Unit& u) const { return A + (long)u.pm * 256 * 1024; }
    __device__ __forceinline__ const char* bptr(const Unit& u) const { return B + (long)u.pn * 256 * 1024; }
};
struct SchedPanel {
    int p; const char* A; const char* B; long rowb;
    __device__ __forceinline__ bool next(int i, Unit& u) const { if (i >= 4) return false; u.pm = p; u.pn = i; return true; }
    __device__ __forceinline__ const char* aptr(const Unit& u) const { return A + (long)u.pm * 256 * rowb; }
    __device__ __forceinline__ const char* bptr(const Unit& u) const { return B + (long)u.pn * 256 * rowb; }
};
struct SchedPlain {
    int G, c, nM, nN, rstride, roff; const char* A; const char* B; long rowb;
    __device__ __forceinline__ bool next(int i, Unit& u) const {
        const int L = i * G + c; if (L >= nM * nN) return false;
        pg8::swz_unit(L, nM, nN, u); return true;
    }
    __device__ __forceinline__ const char* aptr(const Unit& u) const { return A + ((long)u.pm * rstride + roff) * rowb; }
    __device__ __forceinline__ const char* bptr(const Unit& u) const { return B + (long)u.pn * 256 * rowb; }
};

struct EpiIn {
    bf16_t* z; bf16_t* gates; bf16_t* memk; bf16_t* memvt; const float* lbl; const float* gtab; LAS float* hs;
    __device__ __forceinline__ void operator()(AccRef acc, const Unit& u, int wr, int wc, int fr, int fq) const {
        const int ty = u.pm >> 10, idx = u.pm & 1023, pn = u.pn;
        bf16_t* base; size_t ldc; int mode = 0; int c0; int rbase;
        if (ty == 1) {
            const int tk = pn * 256 + wc * 32 + 8 * fq; const int b = tk >> 11;
            base = z + 6 * ((size_t)MTOK * 512) + (size_t)b * 512 * 2048; ldc = 2048; c0 = tk & 2047; rbase = idx * 256 + wr * 64 + fr;
        } else if (ty == 3) {
            const int mi = pn * 256 + wc * 32 + 8 * fq; const int b = mi >> 8;
            base = memvt + (size_t)b * 512 * 256; ldc = 256; c0 = mi & 255; rbase = idx * 256 + wr * 64 + fr;
        } else if (ty == 2) {
            base = memk; ldc = 512; c0 = (pn - 28) * 256 + wc * 32 + 8 * fq; rbase = idx * 256 + wr * 64 + fr; mode = 5;
        } else if (pn >= 16) {
            base = gates; ldc = 3072; c0 = (pn - 16) * 256 + wc * 32 + 8 * fq; rbase = idx * 256 + wr * 64 + fr; mode = 3;
        } else { const int reg = pn >> 1;
            base = z + (size_t)reg * ((size_t)MTOK * 512); ldc = 512; c0 = (pn & 1) * 256 + wc * 32 + 8 * fq; rbase = idx * 256 + wr * 64 + fr;
            mode = (reg == 0 || reg == 3) ? 1 : (reg == 1 ? 2 : ((reg == 4 || reg == 5) ? 4 : (reg == 7 ? 5 : 0)));
        }
        if (mode >= 4) {
            const int rloc = wr * 64 + fr; const bool wide = (mode == 5); const bool isq = wide ? (ty == 0) : (pn < 10);
#pragma unroll
            for (int ai = 0; ai < 2; ++ai)
#pragma unroll
                for (int m = 0; m < 4; ++m)
#pragma unroll
                    for (int bj = 0; bj < 2; ++bj) { const f32x4 a0 = acc[ai][bj][m][0], a1 = acc[ai][bj][m][1];
                        float sq = (a0[0] * a0[0] + a0[1] * a0[1]) + (a0[2] * a0[2] + a0[3] * a0[3]) + (a1[0] * a1[0] + a1[1] * a1[1]) + (a1[2] * a1[2] + a1[3] * a1[3]);
                        sq += sxor<16>(sq); sq += sxor<32>(sq);
                        if (fq == 0) hs[((rloc + ai * 128 + m * 16) * 2 + bj) * 4 + wc] = sq; }
            asm volatile("s_waitcnt lgkmcnt(0)" ::: "memory");
            __builtin_amdgcn_s_barrier();
            const float* gp = gtab + (wide ? (isq ? 128 : 256) + wc * 32 : (isq ? 0 : 64) + (wc & 1) * 32) + 8 * fq;
            const float gsc = isq ? (wide ? 0.08838834764831845f : 0.125f) * 1.4426950408889634f : 1.f;
            float gg[8];
#pragma unroll
            for (int i = 0; i < 8; ++i) gg[i] = gp[i] * gsc;
#pragma unroll
            for (int ai = 0; ai < 2; ++ai)
#pragma unroll
                for (int m = 0; m < 4; ++m)
#pragma unroll
                    for (int bj = 0; bj < 2; ++bj) { const LAS float* hp = hs + ((rloc + ai * 128 + m * 16) * 2 + bj) * 4; const f32x4 h4 = *(const LAS f32x4*)hp;
                        const float rs = wide ? __builtin_amdgcn_rsqf(((h4[0] + h4[1]) + (h4[2] + h4[3])) * (1.f / 128.f) + EPS) : __builtin_amdgcn_rsqf(((wc & 2) ? (h4[2] + h4[3]) : (h4[0] + h4[1])) * (1.f / 64.f) + EPS);
                        const f32x4 a0 = acc[ai][bj][m][0], a1 = acc[ai][bj][m][1];
                        u32x4 w; w.x = pk2(a0[0] * rs * gg[0], a0[1] * rs * gg[1]); w.y = pk2(a0[2] * rs * gg[2], a0[3] * rs * gg[3]); w.z = pk2(a1[0] * rs * gg[4], a1[1] * rs * gg[5]); w.w = pk2(a1[2] * rs * gg[6], a1[3] * rs * gg[7]);
                        *(u32x4*)(base + (size_t)(rbase + ai * 128 + m * 16) * ldc + c0 + bj * 128) = w; }
            return;
        }
#pragma unroll
        for (int bj = 0; bj < 2; ++bj) {
            float lb[8];
            if (mode == 2) {
#pragma unroll
                for (int i = 0; i < 8; ++i) { const float l0 = lbl[c0 + bj * 128 + i], l1 = lbl[512 + c0 + bj * 128 + i]; lb[i] = __builtin_amdgcn_rcpf(1.f + __expf(l1 - l0)); }
            }
#pragma unroll
            for (int ai = 0; ai < 2; ++ai)
#pragma unroll
                for (int m = 0; m < 4; ++m) { float v[8];
#pragma unroll
                    for (int i = 0; i < 8; ++i) v[i] = acc[ai][bj][m][i >> 2][i & 3];
                    if (mode == 1) {
#pragma unroll
                        for (int i = 0; i < 8; ++i) v[i] = v[i] * sigmoidf_(v[i]);
                    } else if (mode == 2) {
#pragma unroll
                        for (int i = 0; i < 8; ++i) v[i] = __logf(lb[i] + (1.f - lb[i]) * sigmoidf_(v[i]));
                    } else if (mode == 3) {
#pragma unroll
                        for (int i = 0; i < 8; ++i) v[i] = sigmoidf_(v[i]);
                    }
                    u32x4 w; w.x = pk2(v[0], v[1]); w.y = pk2(v[2], v[3]); w.z = pk2(v[4], v[5]); w.w = pk2(v[6], v[7]);
                    *(u32x4*)(base + (size_t)(rbase + ai * 128 + m * 16) * ldc + c0 + bj * 128) = w; }
        }
    }
};

struct EpiMerge {
    const bf16_t* gates; bf16_t* part; bf16_t* merged;
    __device__ __forceinline__ void operator()(AccRef acc, const Unit& u, int wr, int wc, int fr, int fq) const {
        const int j = u.pm >> 8, pm = u.pm & 255, pn = u.pn & 3;
        const int rbase = pm * 256 + wr * 64 + fr, c0 = pn * 256 + wc * 32 + 8 * fq;
#pragma unroll
        for (int ai = 0; ai < 2; ++ai)
#pragma unroll
            for (int m = 0; m < 4; ++m) { const size_t r = (size_t)(rbase + ai * 128 + m * 16);
#pragma unroll
                for (int bj = 0; bj < 2; ++bj) { const int c = c0 + bj * 128;
                    const u32x4 gw = *(const u32x4*)(gates + r * 3072 + j * 1024 + c);
                    f32x4 v0 = acc[ai][bj][m][0], v1 = acc[ai][bj][m][1];
                    v0[0] *= bflo(gw.x); v0[1] *= bfhi(gw.x); v0[2] *= bflo(gw.y); v0[3] *= bfhi(gw.y);
                    v1[0] *= bflo(gw.z); v1[1] *= bfhi(gw.z); v1[2] *= bflo(gw.w); v1[3] *= bfhi(gw.w);
                    if (j == 2) { const u32x4 p0 = *(const u32x4*)(part + r * 1024 + c), p1 = *(const u32x4*)(part + (size_t)MTOK * 1024 + r * 1024 + c);
                        v0[0] += bflo(p0.x) + bflo(p1.x); v0[1] += bfhi(p0.x) + bfhi(p1.x); v0[2] += bflo(p0.y) + bflo(p1.y); v0[3] += bfhi(p0.y) + bfhi(p1.y);
                        v1[0] += bflo(p0.z) + bflo(p1.z); v1[1] += bfhi(p0.z) + bfhi(p1.z); v1[2] += bflo(p0.w) + bflo(p1.w); v1[3] += bfhi(p0.w) + bfhi(p1.w); }
                    u32x4 w; w.x = pk2(v0[0], v0[1]); w.y = pk2(v0[2], v0[3]); w.z = pk2(v1[0], v1[1]); w.w = pk2(v1[2], v1[3]);
                    bf16_t* dst = (j == 2) ? merged : part + (size_t)j * MTOK * 1024;
                    *(u32x4*)(dst + r * 1024 + c) = w; } }
    }
};

struct EpiOut {
    const float* x; bf16_t* x1b; float* rstd; LAS float* rowss; int wv;
    __device__ __forceinline__ void operator()(AccRef acc, const Unit& u, int wr, int wc, int fr, int fq) const {
        const int rloc = wr * 64 + fr, rbase = u.pm * 256 + rloc, c0 = u.pn * 256 + wc * 32 + 8 * fq;
#pragma unroll
        for (int ai = 0; ai < 2; ++ai)
#pragma unroll
            for (int m = 0; m < 4; ++m) { const size_t r = (size_t)(rbase + ai * 128 + m * 16); float sq = 0.f;
#pragma unroll
                for (int bj = 0; bj < 2; ++bj) { const int c = c0 + bj * 128;
                    f32x4 v0 = acc[ai][bj][m][0] + *(const f32x4*)(x + r * 1024 + c), v1 = acc[ai][bj][m][1] + *(const f32x4*)(x + r * 1024 + c + 4);
                    sq += v0[0] * v0[0] + v0[1] * v0[1] + v0[2] * v0[2] + v0[3] * v0[3] + v1[0] * v1[0] + v1[1] * v1[1] + v1[2] * v1[2] + v1[3] * v1[3];
                    u32x4 w; w.x = pk2(v0[0], v0[1]); w.y = pk2(v0[2], v0[3]); w.z = pk2(v1[0], v1[1]); w.w = pk2(v1[2], v1[3]); *(u32x4*)(x1b + r * 1024 + c) = w; }
                sq += sxor<16>(sq); sq += sxor<32>(sq);
                if (fq == 0) { LAS float* sl = rowss + (rloc + ai * 128 + m * 16) * 4 + wc; *sl = (u.pn == 0) ? sq : (*sl + sq); } }
        if (u.pn == 3) {
            asm volatile("s_waitcnt lgkmcnt(0)" ::: "memory");
            __builtin_amdgcn_s_barrier();
            const int t = tid_from(wv);
            if (t < 256) { const f32x4 q = *(const LAS f32x4*)(rowss + t * 4); rstd[u.pm * 256 + t] = __builtin_amdgcn_rsqf(((q[0] + q[1]) + (q[2] + q[3])) * (1.f / 1024.f) + EPS); }
            asm volatile("s_waitcnt lgkmcnt(0)" ::: "memory");
            __builtin_amdgcn_s_barrier();
        }
    }
};

template <int CTRL> __device__ __forceinline__ float dppf(float v) {
    return __builtin_bit_cast(float, __builtin_amdgcn_update_dpp(0, __builtin_bit_cast(int, v), CTRL, 0xf, 0xf, true));
}
struct EpiUp {
    const float* ss; const float* cw; const float* cb; bf16_t* y; LAS float* hal;
    __device__ __forceinline__ void operator()(AccRef acc, const Unit& u, int wr, int wc, int fr, int fq) const {
        const int R0 = 254 * u.pm - 2 + wr * 64 + fr;
        const int chl = wc * 32 + 8 * fq;
        const int gch = u.pn * 128 + chl;
#pragma unroll
        for (int ai = 0; ai < 2; ++ai)
#pragma unroll
            for (int m = 0; m < 4; ++m) { const int R = R0 + ai * 128 + m * 16; float rs = 0.f;
                if (R >= 0 && R < MTOK) rs = ss[R];
#pragma unroll
                for (int bj = 0; bj < 2; ++bj)
#pragma unroll
                    for (int n = 0; n < 2; ++n) acc[ai][bj][m][n] = acc[ai][bj][m][n] * rs; }
        if (fr >= 14) {
#pragma unroll
            for (int ai = 0; ai < 2; ++ai) { LAS float* hp = hal + ((2 * ai + wr) * 2 + (fr - 14)) * 128 + chl;
                *(LAS f32x4*)hp = acc[ai][0][3][0]; *(LAS f32x4*)(hp + 4) = acc[ai][0][3][1]; }
        }
        asm volatile("s_waitcnt lgkmcnt(0)" ::: "memory");
        __builtin_amdgcn_s_barrier();
        f32x4 w0[2], w1[2], w2[2], bb[2];
#pragma unroll
        for (int n = 0; n < 2; ++n) { w0[n] = *(const f32x4*)(cw + gch + 4 * n); w1[n] = *(const f32x4*)(cw + FFD + gch + 4 * n); w2[n] = *(const f32x4*)(cw + 2 * FFD + gch + 4 * n); bb[n] = *(const f32x4*)(cb + gch + 4 * n); }
#pragma unroll
        for (int ai = 0; ai < 2; ++ai) { const int blk = 2 * ai + wr;
            f32x4 H[2]; H[0] = (f32x4){0.f, 0.f, 0.f, 0.f}; H[1] = H[0];
            if (fr >= 14 && blk >= 1) { const LAS float* hp = hal + ((blk - 1) * 2 + (fr - 14)) * 128 + chl; H[0] = *(const LAS f32x4*)hp; H[1] = *(const LAS f32x4*)(hp + 4); }
#pragma unroll
            for (int m = 3; m >= 0; --m) { const int tr = ai * 128 + wr * 64 + m * 16 + fr; const int R = R0 + ai * 128 + m * 16; const int tt = R & 2047;
                float o[8];
#define CONV_TAPS(MASKED) _Pragma("unroll") for (int n = 0; n < 2; ++n) _Pragma("unroll") for (int e = 0; e < 4; ++e) { const float xc = acc[ai][0][m][n][e]; const float xp = (m == 0) ? H[n][e] : acc[ai][0][m > 0 ? m - 1 : 0][n][e]; \
                        float p1 = __builtin_bit_cast(float, __builtin_amdgcn_update_dpp(__builtin_bit_cast(int, dppf<0x121>(xp)), __builtin_bit_cast(int, xc), 0x111, 0xf, 0xf, false)); \
                        float p2 = __builtin_bit_cast(float, __builtin_amdgcn_update_dpp(__builtin_bit_cast(int, dppf<0x122>(xp)), __builtin_bit_cast(int, xc), 0x112, 0xf, 0xf, false)); \
                        if (MASKED) { if (tt < 1) p1 = 0.f; if (tt < 2) p2 = 0.f; } \
                        o[4 * n + e] = w2[n][e] * xc + w1[n][e] * p1 + w0[n][e] * p2 + bb[n][e]; }
                if (((254 * u.pm - 2 + wr * 64 + ai * 128 + m * 16 + 15) & 2047) <= 16) { CONV_TAPS(true) } else { CONV_TAPS(false) }
#undef CONV_TAPS
                if (tr >= 2 && R < MTOK) {
                    const f32x2 g0 = pg8::gelu_pk((f32x2){o[0], o[1]}), g1 = pg8::gelu_pk((f32x2){o[2], o[3]}), g2 = pg8::gelu_pk((f32x2){o[4], o[5]}), g3 = pg8::gelu_pk((f32x2){o[6], o[7]});
                    const f32x4 v0 = acc[ai][1][m][0], v1 = acc[ai][1][m][1];
                    u32x4 w; w.x = pk2(g0.x * v0[0], g0.y * v0[1]); w.y = pk2(g1.x * v0[2], g1.y * v0[3]); w.z = pk2(g2.x * v1[0], g2.y * v1[1]); w.w = pk2(g3.x * v1[2], g3.y * v1[3]);
                    *(u32x4*)(y + (size_t)R * FFD + gch) = w; } } }
    }
};

struct EpiDown {
    const bf16_t* x1b; float* out;
    __device__ __forceinline__ void operator()(AccRef acc, const Unit& u, int wr, int wc, int fr, int fq) const {
        const int rbase = u.pm * 256 + wr * 64 + fr, c0 = u.pn * 256 + wc * 32 + 8 * fq;
#pragma unroll
        for (int ai = 0; ai < 2; ++ai)
#pragma unroll
            for (int m = 0; m < 4; ++m) { const size_t r = (size_t)(rbase + ai * 128 + m * 16);
#pragma unroll
                for (int bj = 0; bj < 2; ++bj) { const size_t o = r * 1024 + c0 + bj * 128; const u32x4 xw = *(const u32x4*)(x1b + o);
                    f32x4 v0 = acc[ai][bj][m][0], v1 = acc[ai][bj][m][1];
                    v0[0] += bflo(xw.x); v0[1] += bfhi(xw.x); v0[2] += bflo(xw.y); v0[3] += bfhi(xw.y); v1[0] += bflo(xw.z); v1[1] += bfhi(xw.z); v1[2] += bflo(xw.w); v1[3] += bfhi(xw.w);
                    *(f32x4*)(out + o) = v0; *(f32x4*)(out + o + 4) = v1; } }
    }
};

__device__ __forceinline__ void transpose_item(const float* W, int ldw, int K, bf16_t* WT, int n0, int sc0, int k0, const float* ksc, LAS float* scr, int lane) {
#pragma unroll
    for (int i = 0; i < 32; ++i) { const int kk = 2 * i + (lane >> 5); float w = W[(size_t)(k0 + kk) * ldw + sc0 + (lane & 31)]; if (ksc) w *= ksc[k0 + kk]; scr[kk * 33 + (lane & 31)] = w; }
    asm volatile("s_waitcnt lgkmcnt(0)" ::: "memory");
    const int c = lane & 7;
#pragma unroll
    for (int j = 0; j < 4; ++j) { const int n = (lane >> 3) + 8 * j; const LAS float* s = scr + (8 * c) * 33 + n;
        u32x4 o; o.x = pk2(s[0 * 33], s[1 * 33]); o.y = pk2(s[2 * 33], s[3 * 33]); o.z = pk2(s[4 * 33], s[5 * 33]); o.w = pk2(s[6 * 33], s[7 * 33]);
        *(u32x4*)(WT + (size_t)(n0 + n) * K + k0 + 8 * c) = o; }
    asm volatile("s_waitcnt lgkmcnt(0)" ::: "memory");
}

struct Params {
    const float* in[22]; float* out; unsigned char* ws;
};

template <bool FF> __device__ __forceinline__ void norm_rows(const float* xbase, int nrows, int gw, int NGW, const float* g, bf16_t* obase, const LAS float* ffw, const float* fbias, float* flog, int lane) {
    f32x4 gr[4];
#pragma unroll
    for (int j = 0; j < 4; ++j) gr[j] = ((const f32x4*)g)[lane + 64 * j];
    f32x4 nv[2][4];
#pragma unroll
    for (int r = 0; r < 2; ++r) { const int m = gw + r * NGW; const int mc = m < nrows ? m : nrows - 1;
#pragma unroll
        for (int j = 0; j < 4; ++j) nv[r][j] = ((const f32x4*)(xbase + (size_t)mc * DM))[lane + 64 * j]; }
    for (int m0 = gw; m0 < nrows; m0 += 2 * NGW) {
        f32x4 v[2][4]; float s[2];
#pragma unroll
        for (int r = 0; r < 2; ++r) { s[r] = 0.f;
#pragma unroll
            for (int j = 0; j < 4; ++j) { v[r][j] = nv[r][j]; s[r] += (v[r][j][0] * v[r][j][0] + v[r][j][1] * v[r][j][1]) + (v[r][j][2] * v[r][j][2] + v[r][j][3] * v[r][j][3]); } }
#pragma unroll
        for (int r = 0; r < 2; ++r) { const int m = m0 + (2 + r) * NGW; const int mc = m < nrows ? m : nrows - 1;
#pragma unroll
            for (int j = 0; j < 4; ++j) nv[r][j] = ((const f32x4*)(xbase + (size_t)mc * DM))[lane + 64 * j]; }
        s[0] = xsum64(s[0]); s[1] = xsum64(s[1]);
        float dd[2][8];
#pragma unroll
        for (int r = 0; r < 2; ++r) { const int m = m0 + r * NGW; const bool ok = m < nrows;
            const float rstd = __builtin_amdgcn_rsqf(s[r] * (1.f / DM) + EPS);
#pragma unroll
            for (int j = 0; j < 4; ++j) v[r][j] = v[r][j] * rstd * gr[j];
            if (ok) { u32x2* o8 = (u32x2*)(obase + (size_t)m * DM) + lane;
#pragma unroll
                for (int j = 0; j < 4; ++j) { u32x2 w; w.x = pk2(v[r][j][0], v[r][j][1]); w.y = pk2(v[r][j][2], v[r][j][3]); o8[64 * j] = w; } } }
        if (FF) {
#pragma unroll
            for (int jj = 0; jj < 8; ++jj) { float t0 = 0.f, t1 = 0.f;
#pragma unroll
                for (int j = 0; j < 4; ++j) { const f32x4 w = *(const LAS f32x4*)(ffw + jj * 1024 + 4 * (lane + 64 * j));
                    t0 += v[0][j][0] * w[0] + v[0][j][1] * w[1] + v[0][j][2] * w[2] + v[0][j][3] * w[3]; t1 += v[1][j][0] * w[0] + v[1][j][1] * w[1] + v[1][j][2] * w[2] + v[1][j][3] * w[3]; }
                dd[0][jj] = t0; dd[1][jj] = t1; }
            const bool b5 = (lane & 32) != 0, b4 = (lane & 16) != 0, b3 = (lane & 8) != 0;
            float rr[2];
#pragma unroll
            for (int r = 0; r < 2; ++r) { float k4[4], k2[2];
#pragma unroll
                for (int j = 0; j < 4; ++j) { const float snd = b5 ? dd[r][j] : dd[r][j + 4], kp = b5 ? dd[r][j + 4] : dd[r][j]; k4[j] = kp + sxor<32>(snd); }
#pragma unroll
                for (int j = 0; j < 2; ++j) { const float snd = b4 ? k4[j] : k4[j + 2], kp = b4 ? k4[j + 2] : k4[j]; k2[j] = kp + sxor<16>(snd); }
                { const float snd = b3 ? k2[0] : k2[1], kp = b3 ? k2[1] : k2[0]; rr[r] = kp + sxor<8>(snd); }
                rr[r] += sxor<4>(rr[r]); rr[r] += sxor<2>(rr[r]); rr[r] += sxor<1>(rr[r]); }
            if ((lane & 7) == 0) { const int jj = lane >> 3;
#pragma unroll
                for (int r = 0; r < 2; ++r) { const int m = m0 + r * NGW; if (m < nrows) { const float zz = rr[r] + fbias[jj]; flog[(size_t)m * 8 + jj] = fminf(zz, 0.f) - log1pf(__expf(-fabsf(zz))); } } }
        }
    }
}

typedef float f32x16 __attribute__((ext_vector_type(16)));
__device__ __forceinline__ float swapmax(float v) { auto rr = __builtin_amdgcn_permlane32_swap(__float_as_uint(v), __float_as_uint(v), false, false); const unsigned a = rr[0], b = rr[1]; return fmaxf(__uint_as_float(a), __uint_as_float(b)); }
__device__ __forceinline__ float swapsum(float v) { auto rr = __builtin_amdgcn_permlane32_swap(__float_as_uint(v), __float_as_uint(v), false, false); const unsigned a = rr[0], b = rr[1]; return __uint_as_float(a) + __uint_as_float(b); }
template <int D, bool FOX, int KS, int VS>
__device__ __forceinline__ void attn_tile(const LAS bf16_t* Ks, const LAS bf16_t* Vs, const bf16x8 (&qf)[D / 16], const bf16x8 qx, f32x16 (&O)[D / 32], float& mrow, float& lrow,
                                          int k0, int q0w, int r32, int hi) {
    f32x16 s[2];
#pragma unroll
    for (int kb = 0; kb < 2; ++kb) {
#pragma unroll
        for (int j = 0; j < 16; ++j) s[kb][j] = 0.f;
#pragma unroll
        for (int ks = 0; ks < D / 16; ++ks) { const bf16x8 kf = *(const LAS bf16x8*)(Ks + (32 * kb + r32) * KS + 16 * ks + 8 * hi);
            s[kb] = __builtin_amdgcn_mfma_f32_32x32x16_bf16(kf, qf[ks], s[kb], 0, 0, 0); }
        if (FOX) {
            const bf16x8 kx = *(const LAS bf16x8*)(Ks + (32 * kb + r32) * KS + D + 8 * hi);
            s[kb] = __builtin_amdgcn_mfma_f32_32x32x16_bf16(kx, qx, s[kb], 0, 0, 0); } }
    if (FOX) {
        if (k0 + 63 > q0w) {
#pragma unroll
            for (int kb = 0; kb < 2; ++kb)
#pragma unroll
                for (int j = 0; j < 16; ++j) { const int key = k0 + 32 * kb + 8 * (j >> 2) + 4 * hi + (j & 3); if (key > q0w + r32) s[kb][j] = -1e30f; }
        }
    }
    float mx = fmaxf(s[0][0], s[1][0]);
#pragma unroll
    for (int j = 1; j < 16; ++j) mx = fmaxf(mx, fmaxf(s[0][j], s[1][j]));
    mx = swapmax(mx);
    if (__builtin_amdgcn_ballot_w64(mx > mrow) != 0ull) {
        const float mn = fmaxf(mrow, mx); const float al = __builtin_amdgcn_exp2f(mrow - mn); mrow = mn;
        lrow = lrow * al;
#pragma unroll
        for (int i = 0; i < D / 32; ++i) O[i] = O[i] * al;
    }
    const float mn = mrow;
    float ps = 0.f;
#pragma unroll
    for (int kb = 0; kb < 2; ++kb)
#pragma unroll
        for (int j = 0; j < 16; ++j) { const float p = __builtin_amdgcn_exp2f(s[kb][j] - mn); s[kb][j] = p; ps += p; }
    lrow += ps;
#pragma unroll
    for (int kb = 0; kb < 2; ++kb)
#pragma unroll
        for (int sx = 0; sx < 2; ++sx) { u32x4 pw; pw.x = pk2(s[kb][8 * sx + 0], s[kb][8 * sx + 1]); pw.y = pk2(s[kb][8 * sx + 2], s[kb][8 * sx + 3]); pw.z = pk2(s[kb][8 * sx + 4], s[kb][8 * sx + 5]); pw.w = pk2(s[kb][8 * sx + 6], s[kb][8 * sx + 7]);
            const bf16x8 pf = __builtin_bit_cast(bf16x8, pw);
#pragma unroll
            for (int db = 0; db < D / 32; ++db) { const LAS bf16_t* vp = Vs + (32 * db + r32) * VS + 32 * kb + 16 * sx + 4 * hi;
                const u32x2 lo = *(const LAS u32x2*)vp, hi2 = *(const LAS u32x2*)(vp + 8); const u32x4 vw = {lo.x, lo.y, hi2.x, hi2.y};
                O[db] = __builtin_amdgcn_mfma_f32_32x32x16_bf16(__builtin_bit_cast(bf16x8, vw), pf, O[db], 0, 0, 0); } }
}
template <int D> __device__ __forceinline__ void q_frags(const u32x4 (&qw)[D / 16], const float* qg, float scale, int hi, bf16x8 (&qf)[D / 16]) {
    float ssq = 0.f;
#pragma unroll
    for (int ks = 0; ks < D / 16; ++ks) { const float t0 = bflo(qw[ks].x), t1 = bfhi(qw[ks].x), t2 = bflo(qw[ks].y), t3 = bfhi(qw[ks].y), t4 = bflo(qw[ks].z), t5 = bfhi(qw[ks].z), t6 = bflo(qw[ks].w), t7 = bfhi(qw[ks].w);
        ssq += (t0 * t0 + t1 * t1) + (t2 * t2 + t3 * t3) + (t4 * t4 + t5 * t5) + (t6 * t6 + t7 * t7); }
    ssq = swapsum(ssq);
    const float rs = scale * __builtin_amdgcn_rsqf(ssq * (1.f / D) + EPS);
#pragma unroll
    for (int ks = 0; ks < D / 16; ++ks) { const f32x4 g0 = *(const f32x4*)(qg + 16 * ks + 8 * hi), g1 = *(const f32x4*)(qg + 16 * ks + 8 * hi + 4); u32x4 w;
        w.x = pk2(bflo(qw[ks].x) * rs * g0[0], bfhi(qw[ks].x) * rs * g0[1]); w.y = pk2(bflo(qw[ks].y) * rs * g0[2], bfhi(qw[ks].y) * rs * g0[3]);
        w.z = pk2(bflo(qw[ks].z) * rs * g1[0], bfhi(qw[ks].z) * rs * g1[1]); w.w = pk2(bflo(qw[ks].w) * rs * g1[2], bfhi(qw[ks].w) * rs * g1[3]); qf[ks] = __builtin_bit_cast(bf16x8, w); }
}
template <int D> __device__ __forceinline__ void o_store(const f32x16 (&O)[D / 32], float lrow, bf16_t* orow, int hi) {
    const float linv = __builtin_amdgcn_rcpf(swapsum(lrow));
#pragma unroll
    for (int db = 0; db < D / 32; ++db)
#pragma unroll
        for (int g4 = 0; g4 < 4; g4 += 2) {
            unsigned ax = pk2(O[db][4 * g4] * linv, O[db][4 * g4 + 1] * linv), ay = pk2(O[db][4 * g4 + 2] * linv, O[db][4 * g4 + 3] * linv);
            unsigned bx = pk2(O[db][4 * g4 + 4] * linv, O[db][4 * g4 + 5] * linv), by = pk2(O[db][4 * g4 + 6] * linv, O[db][4 * g4 + 7] * linv);
            { auto r = __builtin_amdgcn_permlane32_swap(ax, bx, false, false); const unsigned r0 = r[0], r1 = r[1]; ax = r0; bx = r1; }
            { auto r = __builtin_amdgcn_permlane32_swap(ay, by, false, false); const unsigned r0 = r[0], r1 = r[1]; ay = r0; by = r1; }
            *(u32x4*)(orow + 32 * db + 8 * g4 + (hi ? 8 : 0)) = (u32x4){ax, ay, bx, by}; }
}
__device__ __forceinline__ void o_store_lds64(const f32x16 (&O)[2], float lrow, bf16_t* obase  , int ldo, LAS bf16_t* stg, int r32, int hi, int lane) {
    constexpr int SS_ = 72;
    const float linv = __builtin_amdgcn_rcpf(swapsum(lrow));
#pragma unroll
    for (int db = 0; db < 2; ++db)
#pragma unroll
        for (int g4 = 0; g4 < 4; ++g4) { u32x2 w; w.x = pk2(O[db][4 * g4] * linv, O[db][4 * g4 + 1] * linv); w.y = pk2(O[db][4 * g4 + 2] * linv, O[db][4 * g4 + 3] * linv);
            *(LAS u32x2*)(stg + r32 * SS_ + 32 * db + 8 * g4 + 4 * hi) = w; }
    asm volatile("s_waitcnt lgkmcnt(0)" ::: "memory");
#pragma unroll
    for (int i = 0; i < 4; ++i) { const int row = (lane >> 3) + 8 * i, ch = lane & 7; const u32x4 v = *(const LAS u32x4*)(stg + row * SS_ + 8 * ch);
        *(u32x4*)(obase + (size_t)row * ldo + 8 * ch) = v; }
}

template <int D> __device__ __forceinline__ u32x4 knorm_chunk(const u32x4 w, const float (&kgr)[8]) {
    constexpr int NKC = D / 8; float t[8];
    t[0] = bflo(w.x); t[1] = bfhi(w.x); t[2] = bflo(w.y); t[3] = bfhi(w.y); t[4] = bflo(w.z); t[5] = bfhi(w.z); t[6] = bflo(w.w); t[7] = bfhi(w.w);
    float sq = (t[0] * t[0] + t[1] * t[1]) + (t[2] * t[2] + t[3] * t[3]) + (t[4] * t[4] + t[5] * t[5]) + (t[6] * t[6] + t[7] * t[7]);
    sq += sxor<1>(sq); sq += sxor<2>(sq); sq += sxor<4>(sq); if (NKC == 16) sq += sxor<8>(sq);
    const float rs = __builtin_amdgcn_rsqf(sq * (1.f / D) + EPS);
    u32x4 o4; o4.x = pk2(t[0] * rs * kgr[0], t[1] * rs * kgr[1]); o4.y = pk2(t[2] * rs * kgr[2], t[3] * rs * kgr[3]); o4.z = pk2(t[4] * rs * kgr[4], t[5] * rs * kgr[5]); o4.w = pk2(t[6] * rs * kgr[6], t[7] * rs * kgr[7]);
    return o4;
}

__device__ __forceinline__ void fox_unit(LAS unsigned char* lds, const bf16_t* Qp, const bf16_t* Kp, const bf16_t* Vt, const float* qg, const float* kg, const float* Fc, int q0, int nkt, const int* ktab, bf16_t* Op, const int wv) {
    constexpr int D = 64, KS = D + 16 + 8, VS = 72, ldq = 512, ldk = 512, ldvt = 2048, ldo = 512, NB = 5;
    constexpr int BUFB = 64 * KS * 2 + D * VS * 2;
    constexpr float L2E = 1.4426950408889634f;
    const int tid = tid_from(wv);
    const int wid = wv, lane = tid & 63, r32 = lane & 31, hi = lane >> 5;
    const int q0w = q0 + wid * 32, tq = q0 >> 6, dw = tq + (wid >> 1);
    const int kt0 = __builtin_amdgcn_readfirstlane(ktab[q0 >> 5]), ktw = __builtin_amdgcn_readfirstlane(ktab[q0w >> 5]);
    int nsteps = 0;
#pragma unroll
    for (int w = 0; w < 8; ++w) { const int n = tq + (w >> 1) - __builtin_amdgcn_readfirstlane(ktab[(q0 >> 5) + w]) + 1; nsteps = n > nsteps ? n : nsteps; }
    bf16x8 qf[4];
    { const bf16_t* qrow = Qp + (size_t)(q0w + r32) * ldq + 8 * hi;
#pragma unroll
      for (int ks = 0; ks < 4; ++ks) qf[ks] = *(const bf16x8*)(qrow + 16 * ks); }
    bf16x8 qx;
    { const float F = Fc[q0w + r32] * L2E; const unsigned c1 = f2bf(F); const float r1 = F - bf1((bf16_t)c1); const unsigned c2 = f2bf(r1); const float r2 = r1 - bf1((bf16_t)c2); const unsigned c3 = f2bf(r2);
      u32x4 w = {c1 | (c2 << 16), c3 | (0x3f80u << 16), 0x3f80u | (0x3f80u << 16), 0u}; if (hi) w = (u32x4){0u, 0u, 0u, 0u}; qx = __builtin_bit_cast(bf16x8, w); }
    f32x16 O[2];
#pragma unroll
    for (int i = 0; i < 2; ++i)
#pragma unroll
        for (int j = 0; j < 16; ++j) O[i][j] = 0.f;
    float mrow = -1e30f, lrow = 0.f;
    const int key = tid >> 3, dc = tid & 7;
#define FOX_LOAD(kr, vr, fr_, kt) do { kr = *(const u32x4*)(Kp + (size_t)((kt) * 64 + key) * ldk + 8 * dc); vr = *(const u32x4*)(Vt + (size_t)key * ldvt + (kt) * 64 + 8 * dc); \
        if (tid < 64) fr_ = Fc[(kt) * 64 + tid] * L2E; } while (0)
#define FOX_STAGE(kr, vr, fr_, kt) do { LAS bf16_t* Ks_ = (LAS bf16_t*)(lds + ((kt) % NB) * BUFB); LAS bf16_t* Vs_ = Ks_ + 64 * KS; \
        *(LAS u32x4*)(Ks_ + key * KS + 8 * dc) = kr; *(LAS u32x4*)(Vs_ + key * VS + 8 * dc) = vr; \
        if (tid < 64) { const float F = fr_; const unsigned c1 = f2bf(F); const float r1 = F - bf1((bf16_t)c1); const unsigned c2 = f2bf(r1); const float r2 = r1 - bf1((bf16_t)c2); const unsigned c3 = f2bf(r2); \
            *(LAS u32x4*)(Ks_ + tid * KS + D) = (u32x4){0x3f80u | (0x3f80u << 16), 0x3f80u | ((c1 ^ 0x8000u) << 16), (c2 ^ 0x8000u) | ((c3 ^ 0x8000u) << 16), 0u}; \
            *(LAS u32x4*)(Ks_ + tid * KS + D + 8) = (u32x4){0u, 0u, 0u, 0u}; } } while (0)
    {
        u32x4 k4[4], v4[4]; float f4[4] = {0.f, 0.f, 0.f, 0.f};
#pragma unroll
        for (int j = 0; j < 4; ++j) FOX_LOAD(k4[j], v4[j], f4[j], tq + 3 - j);
#pragma unroll
        for (int j = 0; j < 4; ++j) FOX_STAGE(k4[j], v4[j], f4[j], tq + 3 - j);
    }
    u32x4 kreg, vreg; float fkreg = 0.f;
    if (tq - 1 >= kt0) FOX_LOAD(kreg, vreg, fkreg, tq - 1);
    __syncthreads();
    for (int i = 0; i < nsteps; ++i) {
        const int tl = tq - 1 - i;
        if (tl >= kt0) { FOX_STAGE(kreg, vreg, fkreg, tl); if (tl - 1 >= kt0) FOX_LOAD(kreg, vreg, fkreg, tl - 1); }
        const int t = dw - i;
        if (t >= ktw) {
            const LAS bf16_t* Ks = (const LAS bf16_t*)(lds + (t % NB) * BUFB); const LAS bf16_t* Vs = Ks + 64 * KS;
            attn_tile<64, true, KS, VS>(Ks, Vs, qf, qx, O, mrow, lrow, t * 64, q0w, r32, hi);
        }
        __syncthreads();
    }
#undef FOX_LOAD
#undef FOX_STAGE
    o_store_lds64(O, lrow, Op + (size_t)q0w * ldo, ldo, (LAS bf16_t*)(lds + wid * 4608), r32, hi, lane);
}

__device__ __forceinline__ void mem_unit(LAS unsigned char* lds, const bf16_t* Qp, const bf16_t* Kp, const bf16_t* Vt, const float* qg, const float* kg, bf16_t* Op, const int wv) {
    constexpr int D = 128, KS = D + 8, VS = 264, ldq = 512, ldk = 512, ldvt = 256, ldo = 512;
    constexpr float L2E = 1.4426950408889634f;
    const int tid = tid_from(wv);
    const int wid = wv, lane = tid & 63, r32 = lane & 31, hi = lane >> 5;
    LAS bf16_t* Ks = (LAS bf16_t*)lds; LAS bf16_t* Vs = Ks + 256 * KS;
    bf16x8 qw[8];
    { const bf16_t* qrow = Qp + (size_t)(wid * 32 + r32) * ldq + 8 * hi;
#pragma unroll
      for (int ks = 0; ks < 8; ++ks) qw[ks] = *(const bf16x8*)(qrow + 16 * ks); }
    {
#pragma unroll
      for (int rnd = 0; rnd < 2; ++rnd) { u32x4 kr[4], vr[4];
#pragma unroll
          for (int i = 0; i < 4; ++i) { const int ci = tid + 512 * (4 * rnd + i); const int key = ci >> 4, dc = ci & 15; kr[i] = *(const u32x4*)(Kp + (size_t)key * ldk + 8 * dc);
              const int d = ci >> 5, kc = ci & 31; vr[i] = *(const u32x4*)(Vt + (size_t)d * ldvt + 8 * kc); }
#pragma unroll
          for (int i = 0; i < 4; ++i) { const int ci = tid + 512 * (4 * rnd + i); const int key = ci >> 4, dc = ci & 15; *(LAS u32x4*)(Ks + key * KS + 8 * dc) = kr[i];
              const int d = ci >> 5, kc = ci & 31; *(LAS u32x4*)(Vs + d * VS + 8 * kc) = vr[i]; } } }
    __syncthreads();
    for (int qb = 0; qb < 4; ++qb) {
        bf16x8 qf[8];
#pragma unroll
        for (int ks = 0; ks < 8; ++ks) qf[ks] = qw[ks];
        if (qb + 1 < 4) { const bf16_t* qrow = Qp + (size_t)((qb + 1) * 256 + wid * 32 + r32) * ldq + 8 * hi;
#pragma unroll
            for (int ks = 0; ks < 8; ++ks) qw[ks] = *(const bf16x8*)(qrow + 16 * ks); }
        f32x16 O[4];
#pragma unroll
        for (int i = 0; i < 4; ++i)
#pragma unroll
            for (int j = 0; j < 16; ++j) O[i][j] = 0.f;
        float mrow = -1e30f, lrow = 0.f;
#pragma unroll 1
        for (int kt = 0; kt < 4; ++kt) attn_tile<128, false, KS, VS>(Ks + kt * 64 * KS, Vs + kt * 64, qf, qf[0], O, mrow, lrow, 0, 0, r32, hi);
        o_store<128>(O, lrow, Op + (size_t)(qb * 256 + wid * 32 + r32) * ldo, hi);
    }
    __syncthreads();
}

__device__ __forceinline__ void hgrn_unit(LAS unsigned char* lds, const bf16_t* hq, const bf16_t* hlf, const bf16_t* hi, const bf16_t* hg, const float* ng, bf16_t* ya, int b, int h, const int wv) {
    constexpr int QS = 136, TS = 72, OS = 132;
    LAS bf16_t* QD = (LAS bf16_t*)lds;
    LAS bf16_t* KD = QD + 64 * QS;
    LAS bf16_t* KDT = KD + 64 * QS;
    LAS bf16_t* IT = KDT + 128 * TS;
    LAS bf16_t* AM = IT + 128 * TS;
    LAS float* DV = (LAS float*)(AM + 64 * TS);
    LAS float* SEG = DV + 128;
    LAS float* OB = SEG + 512;
    const int tid = tid_from(wv);
    const int wid = wv, lane = tid & 63, fr = lane & 15, g = lane >> 4;
    const int c = tid & 127, sg = tid >> 7;
    const size_t rowbase = (size_t)b * NT;
    const size_t cbase = rowbase * 512 + h * 128 + c;
    f32x4 S[8];
#pragma unroll
    for (int i = 0; i < 8; ++i) S[i] = (f32x4){0.f, 0.f, 0.f, 0.f};
    bf16_t rq[16], rf[16], ri[16];
#pragma unroll
    for (int tt = 0; tt < 16; ++tt) { const size_t o = cbase + (size_t)(sg * 16 + tt) * 512; rq[tt] = hq[o]; rf[tt] = hlf[o]; ri[tt] = hi[o]; }
    for (int ch = 0; ch < NT / 64; ++ch) {
        float Gl[16]; float run = 0.f;
#pragma unroll
        for (int tt = 0; tt < 16; ++tt) { run += bf1(rf[tt]); Gl[tt] = run; }
        SEG[sg * 128 + c] = run;
        __syncthreads();
        float pre = 0.f, tot = 0.f;
#pragma unroll
        for (int s4 = 0; s4 < 4; ++s4) { const float v = SEG[s4 * 128 + c]; tot += v; if (s4 < sg) pre += v; }
        if (sg == 0) DV[c] = __expf(tot);
        unsigned kp[8], ip[8];
#pragma unroll
        for (int tt = 0; tt < 16; ++tt) { const float G = pre + Gl[tt]; const float qd = bf1(rq[tt]) * __expf(G); const float kd = (1.f - __expf(bf1(rf[tt]))) * __expf(-G);
            const unsigned qb = f2bf_hw(qd), kb = f2bf_hw(kd);
            QD[(16 * sg + tt) * QS + c] = (bf16_t)qb; KD[(16 * sg + tt) * QS + c] = (bf16_t)kb;
            if (tt & 1) { kp[tt >> 1] |= kb << 16; ip[tt >> 1] |= (unsigned)ri[tt] << 16; } else { kp[tt >> 1] = kb; ip[tt >> 1] = (unsigned)ri[tt]; } }
        *(LAS u32x4*)(KDT + c * TS + 16 * sg) = (u32x4){kp[0], kp[1], kp[2], kp[3]}; *(LAS u32x4*)(KDT + c * TS + 16 * sg + 8) = (u32x4){kp[4], kp[5], kp[6], kp[7]};
        *(LAS u32x4*)(IT + c * TS + 16 * sg) = (u32x4){ip[0], ip[1], ip[2], ip[3]}; *(LAS u32x4*)(IT + c * TS + 16 * sg + 8) = (u32x4){ip[4], ip[5], ip[6], ip[7]};
        if (ch + 1 < NT / 64) {
#pragma unroll
            for (int tt = 0; tt < 16; ++tt) { const size_t o = cbase + (size_t)((ch + 1) * 64 + sg * 16 + tt) * 512; rq[tt] = hq[o]; rf[tt] = hlf[o]; ri[tt] = hi[o]; }
        }
        __syncthreads();
        const size_t goff = (rowbase + ch * 64 + (tid >> 3)) * 512 + h * 128 + 16 * (tid & 7);
        const u32x4 g0 = *(const u32x4*)(hg + goff), g1 = *(const u32x4*)(hg + goff + 8);
#pragma unroll
        for (int bi = 0; bi < 2; ++bi) { const int idx = 2 * wid + bi, tb = idx >> 2, sb = idx & 3;
            f32x4 a = (f32x4){0.f, 0.f, 0.f, 0.f};
            if (sb <= tb) {
#pragma unroll
                for (int ks = 0; ks < 4; ++ks) { const bf16x8 qa = *(const LAS bf16x8*)(QD + (16 * tb + fr) * QS + 32 * ks + 8 * g); const bf16x8 kb = *(const LAS bf16x8*)(KD + (16 * sb + fr) * QS + 32 * ks + 8 * g);
                    a = __builtin_amdgcn_mfma_f32_16x16x32_bf16(qa, kb, a, 0, 0, 0); }
            }
#pragma unroll
            for (int e = 0; e < 4; ++e) { const int t = 16 * tb + 4 * g + e, sx = 16 * sb + fr; AM[t * TS + sx] = (bf16_t)f2bf_hw((sx <= t) ? a[e] : 0.f); } }
        __syncthreads();
        bf16x8 itf[2];
#pragma unroll
        for (int k2 = 0; k2 < 2; ++k2) itf[k2] = *(const LAS bf16x8*)(IT + (16 * wid + fr) * TS + 32 * k2 + 8 * g);
        bf16x8 sbf[4];
#pragma unroll
        for (int m4 = 0; m4 < 4; ++m4) { u32x4 w; w.x = pk2(S[2 * m4][0], S[2 * m4][1]); w.y = pk2(S[2 * m4][2], S[2 * m4][3]); w.z = pk2(S[2 * m4 + 1][0], S[2 * m4 + 1][1]); w.w = pk2(S[2 * m4 + 1][2], S[2 * m4 + 1][3]); sbf[m4] = __builtin_bit_cast(bf16x8, w); }
#pragma unroll
        for (int tb = 0; tb < 4; ++tb) { f32x4 O = (f32x4){0.f, 0.f, 0.f, 0.f};
#pragma unroll
            for (int k2 = 0; k2 < 2; ++k2) { const bf16x8 am = *(const LAS bf16x8*)(AM + (16 * tb + fr) * TS + 32 * k2 + 8 * g); O = __builtin_amdgcn_mfma_f32_16x16x32_bf16(am, itf[k2], O, 0, 0, 0); }
#pragma unroll
            for (int m4 = 0; m4 < 4; ++m4) { const u32x2 lo = *(const LAS u32x2*)(QD + (16 * tb + fr) * QS + 32 * m4 + 4 * g), hi2 = *(const LAS u32x2*)(QD + (16 * tb + fr) * QS + 32 * m4 + 16 + 4 * g);
                const u32x4 w = {lo.x, lo.y, hi2.x, hi2.y}; O = __builtin_amdgcn_mfma_f32_16x16x32_bf16(__builtin_bit_cast(bf16x8, w), sbf[m4], O, 0, 0, 0); }
#pragma unroll
            for (int e = 0; e < 4; ++e) OB[(16 * tb + 4 * g + e) * OS + 16 * wid + fr] = O[e]; }
#pragma unroll
        for (int blk = 0; blk < 8; ++blk) {
#pragma unroll
            for (int k2 = 0; k2 < 2; ++k2) { const bf16x8 kt = *(const LAS bf16x8*)(KDT + (16 * blk + fr) * TS + 32 * k2 + 8 * g); S[blk] = __builtin_amdgcn_mfma_f32_16x16x32_bf16(kt, itf[k2], S[blk], 0, 0, 0); }
            const f32x4 dvv = *(const LAS f32x4*)(DV + 16 * blk + 4 * g); S[blk] = S[blk] * dvv; }
        __syncthreads();
        { const int t = tid >> 3, part = tid & 7; const LAS float* op = OB + t * OS + 16 * part;
            const f32x4 o0 = *(const LAS f32x4*)op, o1 = *(const LAS f32x4*)(op + 4), o2 = *(const LAS f32x4*)(op + 8), o3 = *(const LAS f32x4*)(op + 12);
            float sq = (o0[0] * o0[0] + o0[1] * o0[1] + o0[2] * o0[2] + o0[3] * o0[3]) + (o1[0] * o1[0] + o1[1] * o1[1] + o1[2] * o1[2] + o1[3] * o1[3])
                     + (o2[0] * o2[0] + o2[1] * o2[1] + o2[2] * o2[2] + o2[3] * o2[3]) + (o3[0] * o3[0] + o3[1] * o3[1] + o3[2] * o3[2] + o3[3] * o3[3]);
            sq += sxor<1>(sq); sq += sxor<2>(sq); sq += sxor<4>(sq);
            const float rs = __builtin_amdgcn_rsqf(sq * (1.f / 128.f) + EPS);
            const size_t off = (rowbase + ch * 64 + t) * 512 + h * 128 + 16 * part;
            const f32x4 n0 = *(const f32x4*)(ng + 16 * part), n1 = *(const f32x4*)(ng + 16 * part + 4), n2 = *(const f32x4*)(ng + 16 * part + 8), n3 = *(const f32x4*)(ng + 16 * part + 12);
            u32x4 w0, w1;
            w0.x = pk2(o0[0] * rs * n0[0] * bflo(g0.x), o0[1] * rs * n0[1] * bfhi(g0.x)); w0.y = pk2(o0[2] * rs * n0[2] * bflo(g0.y), o0[3] * rs * n0[3] * bfhi(g0.y));
            w0.z = pk2(o1[0] * rs * n1[0] * bflo(g0.z), o1[1] * rs * n1[1] * bfhi(g0.z)); w0.w = pk2(o1[2] * rs * n1[2] * bflo(g0.w), o1[3] * rs * n1[3] * bfhi(g0.w));
            w1.x = pk2(o2[0] * rs * n2[0] * bflo(g1.x), o2[1] * rs * n2[1] * bfhi(g1.x)); w1.y = pk2(o2[2] * rs * n2[2] * bflo(g1.y), o2[3] * rs * n2[3] * bfhi(g1.y));
            w1.z = pk2(o3[0] * rs * n3[0] * bflo(g1.z), o3[1] * rs * n3[1] * bfhi(g1.z)); w1.w = pk2(o3[2] * rs * n3[2] * bflo(g1.w), o3[3] * rs * n3[3] * bfhi(g1.w));
            *(u32x4*)(ya + off) = w0; *(u32x4*)(ya + off + 8) = w1; }
    }
    __syncthreads();
}

__device__ __forceinline__ void grid_bar(unsigned* cnt, unsigned target, const int wv) {
    __syncthreads();
    if (tid_from(wv) == 0) {
        unsigned* flag = cnt + 32;
        const unsigned gen = target / gridDim.x;
        __builtin_amdgcn_fence(__ATOMIC_RELEASE, "agent");
        const unsigned old = __hip_atomic_fetch_add(cnt, 1u, __ATOMIC_RELAXED, __HIP_MEMORY_SCOPE_AGENT);
        if (old == target - 1u) __hip_atomic_store(flag, gen, __ATOMIC_RELAXED, __HIP_MEMORY_SCOPE_AGENT);
        else while (__hip_atomic_load(flag, __ATOMIC_RELAXED, __HIP_MEMORY_SCOPE_AGENT) < gen) __builtin_amdgcn_s_sleep(4);
        __builtin_amdgcn_fence(__ATOMIC_ACQUIRE, "agent");
    }
    __syncthreads();
}

__global__ void __launch_bounds__(512, 2) fwd_mega(Params P) {
    extern __shared__ __attribute__((aligned(16))) unsigned char lds_raw[];
    LAS unsigned char* lds = (LAS unsigned char*)lds_raw;
    cg::grid_group grid = cg::this_grid();
    const int wv = __builtin_amdgcn_readfirstlane((int)threadIdx.x >> 6);
#define tid (tid_from(wv))
#define lane (lane_id())
#define wid wv
    const int G = gridDim.x, bx = blockIdx.x;
#define ws (P.ws)
#define x (P.in[0])
#define mem (P.in[1])
#define norm_mix_g (P.in[2])
#define norm_mem_g (P.in[3])
#define w_in (P.in[4])
#define lb_logits (P.in[5])
#define hgrn_norm_g (P.in[6])
#define fox_f_bias (P.in[7])
#define fox_q_g (P.in[8])
#define fox_k_g (P.in[9])
#define mem_kv_w (P.in[10])
#define mem_q_g (P.in[11])
#define mem_k_g (P.in[12])
#define w_br_h (P.in[13])
#define w_br_f (P.in[14])
#define w_br_m (P.in[15])
#define w_out (P.in[16])
#define norm_ffn_g (P.in[17])
#define w_up (P.in[18])
#define conv_w (P.in[19])
#define conv_b (P.in[20])
#define w_down (P.in[21])
#define out (P.out)
#define ctl ((unsigned*)(ws + WS_CTL * MiB))
#define WCAT ((bf16_t*)(ws + WS_WCAT * MiB))
#define WBR ((bf16_t*)(ws + WS_WBR * MiB))
#define WOUT ((bf16_t*)(ws + WS_WOUT * MiB))
#define WUP ((bf16_t*)(ws + WS_WUP * MiB))
#define WDOWN ((bf16_t*)(ws + WS_WDOWN * MiB))
#define FLOG ((float*)(ws + WS_FLOG * MiB))
#define FC ((float*)(ws + WS_FC * MiB))
#define SS ((float*)(ws + WS_SS * MiB))
#define MEMK ((bf16_t*)(ws + WS_MEMK * MiB))
#define MEMVT ((bf16_t*)(ws + WS_MEMVT * MiB))
#define Z ((bf16_t*)(ws + WS_Z * MiB))
#define GATES ((bf16_t*)(ws + WS_GATES * MiB))
#define ACC32 ((float*)(ws + WS_ACC32 * MiB))
#define MERGED ((bf16_t*)(ws + WS_MERGED * MiB))
#define X1B ((bf16_t*)(ws + WS_X1B * MiB))
#define Y ((bf16_t*)(ws + WS_Y * MiB))
#define HCAT ((bf16_t*)out)
#define YABC ((bf16_t*)out)
    const size_t ZS = (size_t)MTOK * 512;

#ifndef NO_P0
#ifdef DUP_P0
    for (int rep0 = 0; rep0 < 2; ++rep0)
#endif
    {
        if (bx == 0 && tid == 0) { ctl[0] = 0u; ctl[1] = 0u; ctl[64] = 0u; ctl[96] = 0u; }
        if (bx == 0 && tid < 384) { const int t_ = tid; float* gt = (float*)(ctl + 2048); gt[t_] = t_ < 64 ? fox_q_g[t_] : (t_ < 128 ? fox_k_g[t_ - 64] : (t_ < 256 ? mem_q_g[t_ - 128] : mem_k_g[t_ - 256])); }
        LAS float* ffw = (LAS float*)(lds + 73728);
        for (int idx = tid; idx < 8192; idx += 512) { const int k = idx >> 3, jj = idx & 7; ffw[jj * 1024 + k] = w_in[(size_t)k * INC + 3584 + jj]; }
        __syncthreads();
        LAS float* scr = (LAS float*)(lds + wid * 8448);
        const int gw = bx * 8 + wid, NGW = G * 8;
        constexpr int I0 = 16 * 224, I1 = 16 * 32, I2 = 8 * 32, I3 = 16 * 32, I4 = 16 * 176, I5 = 44 * 32;
        constexpr int NIT = I0 + I1 + 3 * I2 + I3 + I4 + I5;
        for (int it = gw; it < NIT; it += NGW) {
            int r = it;
            if (r < I0) { const int kb = r / 224, nb = r % 224, n0 = nb * 32; transpose_item(w_in, INC, 1024, WCAT, n0, n0 < 3584 ? n0 : n0 + 8, kb * 64, nullptr, scr, lane); continue; } r -= I0;
            if (r < I1) { const int kb = r / 32, nb = r % 32; transpose_item(mem_kv_w, 1024, 1024, WCAT + (size_t)7168 * 1024, nb * 32, nb * 32, kb * 64, nullptr, scr, lane); continue; } r -= I1;
            if (r < 3 * I2) { const int j = r / I2, rr = r % I2, kb = rr / 32, nb = rr % 32; const float* W = j == 0 ? w_br_h : (j == 1 ? w_br_f : w_br_m);
                transpose_item(W, 1024, 512, WBR + (size_t)j * 1024 * 512, nb * 32, nb * 32, kb * 64, nullptr, scr, lane); continue; } r -= 3 * I2;
            if (r < I3) { const int kb = r / 32, nb = r % 32; transpose_item(w_out, 1024, 1024, WOUT, nb * 32, nb * 32, kb * 64, nullptr, scr, lane); continue; } r -= I3;
            if (r < I4) { const int kb = r / 176, nb = r % 176, n0 = nb * 32; const int pn = n0 >> 8, bj = (n0 >> 7) & 1, cc = n0 & 127;
                transpose_item(w_up, 2 * FFD, 1024, WUP, n0, bj * FFD + 128 * pn + cc, kb * 64, norm_ffn_g, scr, lane); continue; } r -= I4;
            { const int kb = r / 32, nb = r % 32; transpose_item(w_down, 1024, FFD, WDOWN, nb * 32, nb * 32, kb * 64, nullptr, scr, lane); }
        }
        norm_rows<true>(x, MTOK, gw, NGW, norm_mix_g, HCAT, ffw, fox_f_bias, FLOG, lane);
        norm_rows<false>(mem, MMEM, gw, NGW, norm_mem_g, HCAT + (size_t)MTOK * DM, ffw, nullptr, nullptr, lane);
    }
#endif
    grid.sync();

#ifndef NO_P1
    {
        LAS float* wt = (LAS float*)(lds + LDS_X); LAS float* FcL = (LAS float*)(lds + LDS_X + 1024);
        for (int bh = bx; bh < 256; bh += G) { const int b = bh >> 3, h = bh & 7;
            float v[4]; float run = 0.f;
#pragma unroll
            for (int e = 0; e < 4; ++e) { run += FLOG[((size_t)b * NT + 4 * tid + e) * 8 + h]; v[e] = run; }
            float inc = run;
#pragma unroll
            for (int o = 1; o < 64; o <<= 1) { const int l_ = lane_id(); const float t = __int_as_float(__builtin_amdgcn_ds_bpermute((l_ - o) << 2, __float_as_int(inc))); if (l_ >= o) inc += t; }
            if (lane == 63) wt[wid] = inc;
            __syncthreads();
            float pre = inc - run;
            for (int w = 0; w < wid; ++w) pre += wt[w];
            const f32x4 fc4 = {pre + v[0], pre + v[1], pre + v[2], pre + v[3]};
            *(f32x4*)(FC + (size_t)bh * NT + 4 * tid) = fc4; *(LAS f32x4*)(FcL + 4 * tid) = fc4;
            __syncthreads();
            { float gq = fabsf(fox_q_g[lane]), gk = fabsf(fox_k_g[lane]);
                gq = xmax64(gq); gk = xmax64(gk);
                const float L2 = 2.f * 8.f * 1.02f * gq * gk;
                const int l_ = lane;
                for (int i = 0; i < 8; ++i) { const int rb = 8 * wid + i; bool skip = false;
                    if (l_ < ((rb >> 1) + 1)) skip = (L2 + FcL[32 * rb] - FcL[64 * l_ + 63]) * 1.4426950408889634f < -127.f;
                    const int k0t = __builtin_popcountll(__ballot(skip));
                    if (l_ == 0) ((int*)ctl)[4096 + bh * 64 + rb] = k0t; } }
            __syncthreads();
        }
        SchedIn S{G, bx, (const char*)HCAT, (const char*)WCAT};
        EpiIn E{Z, GATES, MEMK, MEMVT, lb_logits, (const float*)(ctl + 2048), (LAS float*)(lds + LDS_X + 8192)};
#ifdef DUP_P1
        pg8::gemm_phase<EpiIn, SchedIn>(lds, 1024, S, E, wv);
#endif
        pg8::gemm_phase<EpiIn, SchedIn>(lds, 1024, S, E, wv);
    }
#endif
    grid_bar(ctl + 64, 1u * (unsigned)G, wv);

#ifndef NO_P2
    {
        LAS int* slot = (LAS int*)(lds + LDS_BYTES - 64);
#ifdef DUP_P2
        for (int rep = 0; rep < 2; ++rep)
#else
        const int rep = 0;
#endif
        __syncthreads();
        if (tid == 0) *slot = (int)atomicAdd(ctl + rep, 1u);
        for (;;) {
            __syncthreads();
            const int it = *slot;
            if (it >= 128 + 256 + 2048) break;
            unsigned nxt = 0u;
            if (tid == 0) nxt = atomicAdd(ctl + rep, 1u);
            __syncthreads();
            if (it < 128) { hgrn_unit(lds, Z + 0 * ZS, Z + 1 * ZS, Z + 2 * ZS, Z + 3 * ZS, hgrn_norm_g, YABC, it >> 2, it & 3, wv); }
            else if (it < 128 + 256) { const int r = it - 128, half = r & 1, bh = r >> 1, b = bh >> 2, h = bh & 3;
                mem_unit(lds, Z + 7 * ZS + ((size_t)b * NT + half * 1024) * 512 + h * 128, MEMK + (size_t)b * NMEM * 512 + h * 128, MEMVT + (size_t)bh * 128 * 256, mem_q_g, mem_k_g,
                         YABC + 2 * ZS + ((size_t)b * NT + half * 1024) * 512 + h * 128, wv); }
            else { const int r = it - 128 - 256, qb = 7 - (r >> 8), bh = r & 255, b = bh >> 3, h = bh & 7;
                fox_unit(lds, Z + 4 * ZS + (size_t)b * NT * 512 + h * 64, Z + 5 * ZS + (size_t)b * NT * 512 + h * 64, Z + 6 * ZS + (size_t)bh * 64 * 2048, fox_q_g, fox_k_g, FC + (size_t)bh * NT, qb * 256, 4 * (qb + 1), (const int*)ctl + 4096 + bh * 64,
                         YABC + ZS + (size_t)b * NT * 512 + h * 64, wv); }
            if (tid == 0) *slot = (int)nxt;
        }
    }
#endif
    grid_bar(ctl + 64, 2u * (unsigned)G, wv);

#ifndef NO_P3
    for (int p = bx; p < 256; p += G) {
        {
            SchedMerge S{p, (const char*)YABC, (const char*)WBR};
            EpiMerge E{GATES, (bf16_t*)ACC32, MERGED};
            pg8::gemm_phase<EpiMerge, SchedMerge>(lds, 512, S, E, wv);
        }
        __syncthreads();
        {
            SchedPanel S{p, (const char*)MERGED, (const char*)WOUT, 2048};
            EpiOut E{x, X1B, SS, (LAS float*)(lds + LDS_X + 8192), wv};
            pg8::gemm_phase<EpiOut, SchedPanel>(lds, 1024, S, E, wv);
        }
    }
#endif
    grid_bar(ctl + 64, 3u * (unsigned)G, wv);

#ifndef NO_P5
    {
        SchedPlain S{G, bx, 259, 22, 254, -2, (const char*)X1B, (const char*)WUP, 2048};
        EpiUp E{SS, conv_w, conv_b, Y, (LAS float*)(lds + LDS_X + 256)};
#ifdef DUP_P5
        pg8::gemm_phase<EpiUp, SchedPlain>(lds, 1024, S, E, wv);
#endif
        pg8::gemm_phase<EpiUp, SchedPlain>(lds, 1024, S, E, wv);
    }
#endif
    grid_bar(ctl + 64, 4u * (unsigned)G, wv);
#ifdef PROBE_BAR
    grid_bar(ctl + 64, 5u * (unsigned)G, wv); grid_bar(ctl + 64, 6u * (unsigned)G, wv); grid_bar(ctl + 64, 7u * (unsigned)G, wv); grid_bar(ctl + 64, 8u * (unsigned)G, wv); grid_bar(ctl + 64, 9u * (unsigned)G, wv);
#endif

#ifndef NO_P6
    {
        SchedPlain S{G, bx, 256, 4, 256, 0, (const char*)Y, (const char*)WDOWN, 2 * FFD};
        EpiDown E{X1B, out};
        pg8::gemm_phase<EpiDown, SchedPlain>(lds, FFD, S, E, wv);
    }
#endif
}

#undef tid
#undef lane
#undef wid
#undef ws
#undef x
#undef mem
#undef norm_mix_g
#undef norm_mem_g
#undef w_in
#undef lb_logits
#undef hgrn_norm_g
#undef fox_f_bias
#undef fox_q_g
#undef fox_k_g
#undef mem_kv_w
#undef mem_q_g
#undef mem_k_g
#undef w_br_h
#undef w_br_f
#undef w_br_m
#undef w_out
#undef norm_ffn_g
#undef w_up
#undef conv_w
#undef conv_b
#undef w_down
#undef out
#undef ctl
#undef WCAT
#undef WBR
#undef WOUT
#undef WUP
#undef WDOWN
#undef FLOG
#undef FC
#undef SS
#undef MEMK
#undef MEMVT
#undef Z
#undef GATES
#undef ACC32
#undef MERGED
#undef X1B
#undef Y
#undef HCAT
#undef YABC
extern "C" void kernel_launch(void* const* d_in, const int* in_sizes, int n_in, void* d_out, int out_size, void* d_ws, size_t ws_size, hipStream_t stream) {
    static int grid = 0;
    if (grid == 0) {
        int dev = 0, cus = 0, per_cu = 0;
        hipGetDevice(&dev);
        hipDeviceGetAttribute(&cus, hipDeviceAttributeMultiprocessorCount, dev);
        hipFuncSetAttribute((const void*)fwd_mega, hipFuncAttributeMaxDynamicSharedMemorySize, LDS_BYTES);
        hipOccupancyMaxActiveBlocksPerMultiprocessor(&per_cu, (const void*)fwd_mega, 512, LDS_BYTES);
        if (per_cu < 1) per_cu = 1;
        grid = cus * per_cu;
        (void)hipGetLastError();
    }
    Params p{};
    for (int i = 0; i < 22; ++i) p.in[i] = (const float*)d_in[i];
    p.out = (float*)d_out; p.ws = (unsigned char*)d_ws;
    void* args[] = {&p};
    hipError_t e = hipLaunchCooperativeKernel((const void*)fwd_mega, dim3(grid), dim3(512), args, LDS_BYTES, stream);
    if (e != hipSuccess) fprintf(stderr, "cooperative launch failed: %s (grid %d)\n", hipGetErrorString(e), grid);
}
```
